# Optimizing an MI355X kernel written in HIP

```python
import math
import jax, jax.numpy as jnp
from jax import lax
import numpy as np

D_MODEL = 1024
BATCH = 16
SEQ = 256
DEPTH = 4
DEC_BATCH = 4
DEC_SEQ = 2048
PAST_LEN = 512

GRID_W = 64
N_MIXERS = 3
D_FF = -(-8 * D_MODEL // (3 * 256)) * 256
NORM_EPS = 1e-6
FN_GROUPS = 4
FN_GROUP_W = D_MODEL // FN_GROUPS
HY_PROJ = 3
HY_EMB = 33
HY_BANDS = (HY_EMB - 1) // 2
HY_FILT = 64
HY_TARGET = 1e-2
HY_FAST = 0.3
HY_SLOW = 1.5
RW_HEAD = 64
RW_HEADS = D_MODEL // RW_HEAD
RW_DECAY_LORA = 64
RW_AAA_LORA = 64
RW_GATE_LORA = 128
RW_LN_EPS = 64e-5

kernel_name = 'hybrid_fnet_hyena_rwkv7_diffusion_step'


def _n_layers_of_kind(kind):
    return len(range(kind, DEPTH, N_MIXERS))


def rms_norm(x, g):
    xf = x.astype(jnp.float32)
    y = xf * lax.rsqrt(jnp.mean(xf * xf, axis=-1, keepdims=True) + NORM_EPS)
    return (y * g.astype(jnp.float32)).astype(x.dtype)


def shift_prev(x):
    return jnp.pad(x[:, :-1], ((0, 0), (1, 0), (0, 0)))


def shift_next(x):
    return jnp.pad(x[:, 1:], ((0, 0), (0, 1), (0, 0)))


def swiglu(h, w1, w3, w2):
    return (jax.nn.silu(h @ w1) * (h @ w3)) @ w2


def fourier_mixer(h, w_out, b_out):
    b, l, d = h.shape
    hg = h.astype(jnp.float32).reshape(b, l, FN_GROUPS, FN_GROUP_W)
    f = jnp.fft.fft2(hg, axes=(1, 3), norm='ortho').real.reshape(b, l, d)
    return f.astype(h.dtype) @ w_out + b_out


def hyena_filter(l, w1, b1, freq, w2, b2, w3):
    f32 = jnp.float32
    t = jnp.linspace(0.0, 1.0, l, dtype=f32)[:, None]
    ang = 2.0 * math.pi * jnp.arange(l, dtype=f32)[:, None] / l
    bands = jnp.linspace(1e-4, HY_BANDS - 1, HY_BANDS, dtype=f32)[None]
    z = jnp.concatenate([t, jnp.cos(bands * ang), -jnp.sin(bands * ang)], axis=-1)
    hdn = jnp.sin(freq[0] * (z @ w1 + b1))
    hdn = jnp.sin(freq[1] * (hdn @ w2 + b2))
    k = hdn @ w3
    deltas = jnp.linspace(math.log(HY_TARGET) / HY_FAST, math.log(HY_TARGET) / HY_SLOW, D_MODEL, dtype=f32)
    win = jnp.exp(-t * jnp.abs(deltas)[None])
    k_fwd = k[:, :D_MODEL] * win
    k_bwd = k[:, D_MODEL:] * win
    zero = jnp.zeros((1, D_MODEL), f32)
    return jnp.concatenate([k_fwd[:1] + k_bwd[:1], k_fwd[1:], zero, k_bwd[1:][::-1]], axis=0)


def hyena_mixer(h, w_in, b_in, conv_w, conv_b, f_w1, f_b1, f_freq, f_w2, f_b2, f_w3, d_skip, w_out, b_out):
    b, l, d = h.shape
    f32 = jnp.float32
    u = h @ w_in + b_in
    u = shift_prev(u) * conv_w[0] + u * conv_w[1] + shift_next(u) * conv_w[2] + conv_b
    x0, x1, v = jnp.split(u, HY_PROJ, axis=-1)
    k_full = hyena_filter(l, f_w1.astype(f32), f_b1.astype(f32), f_freq.astype(f32),
                          f_w2.astype(f32), f_b2.astype(f32), f_w3.astype(f32))
    z = (v * x1).astype(f32)
    n = 2 * l
    y = jnp.fft.irfft(jnp.fft.rfft(z, n=n, axis=1) * jnp.fft.rfft(k_full, axis=0)[None], n=n, axis=1)[:, :l]
    y = y + z * d_skip.astype(f32)
    return (y.astype(h.dtype) * x0) @ w_out + b_out


def wkv7_scan(r, decay, k, v, kk, a, s0, reverse):
    def step(s, inp):
        r_t, w_t, k_t, v_t, kk_t, a_t = inp
        sa = jnp.einsum('bhvk,bhk->bhv', s, -kk_t)
        s = (s * w_t[:, :, None, :] + sa[..., None] * (kk_t * a_t)[:, :, None, :]
             + v_t[..., None] * k_t[:, :, None, :])
        return s, jnp.einsum('bhvk,bhk->bhv', s, r_t)
    xs = tuple(jnp.swapaxes(t, 0, 1) for t in (r, decay, k, v, kk, a))
    s_fin, o = lax.scan(step, s0, xs, reverse=reverse)
    return jnp.swapaxes(o, 0, 1), s_fin


def rwkv7_mixer(h, s0_fwd, s0_bwd, mix, wr, wk, wv, wo, w0, w1, w2, a0, a1, a2, g1, g2,
                k_k, k_a, r_k, lnx_w, lnx_b):
    b, l, d = h.shape
    f32 = jnp.float32

    def heads(t):
        return t.astype(f32).reshape(b, l, RW_HEADS, RW_HEAD)

    xx = 0.5 * (shift_prev(h) + shift_next(h)) - h
    xr, xw, xk, xv, xa, xg = (h + xx * mix[m] for m in range(6))
    r = heads(xr @ wr)
    k = heads(xk @ wk)
    v = heads(xv @ wv)
    g = jax.nn.sigmoid(xg @ g1) @ g2
    kk = k * k_k.astype(f32).reshape(RW_HEADS, RW_HEAD)
    kk = kk / jnp.maximum(jnp.sqrt(jnp.sum(kk * kk, axis=-1, keepdims=True)), 1e-12)
    ka = k_a.astype(f32).reshape(RW_HEADS, RW_HEAD)
    rk = r_k.astype(f32)
    outs, bonuses, finals = [], [], []
    for dd, (s0, rev) in enumerate(((s0_fwd, False), (s0_bwd, True))):
        w_log = -jax.nn.softplus(-(w0[dd] + jnp.tanh(xw @ w1[dd]) @ w2[dd]).astype(f32)) - 0.5
        decay = heads(jnp.exp(-jnp.exp(w_log)))
        a = heads(jax.nn.sigmoid(a0[dd] + (xa @ a1[dd]) @ a2[dd]))
        kd = k * (1.0 + (a - 1.0) * ka)
        o_d, s_fin = wkv7_scan(r, decay, kd, v, kk, a, s0.astype(f32), rev)
        outs.append(o_d)
        bonuses.append(jnp.sum(r * kd * rk, axis=-1, keepdims=True) * v)
        finals.append(s_fin)
    o = outs[0] + outs[1]
    mu = jnp.mean(o, axis=-1, keepdims=True)
    var = jnp.mean(jnp.square(o - mu), axis=-1, keepdims=True)
    o = ((o - mu) * lax.rsqrt(var + RW_LN_EPS)).reshape(b, l, d) * lnx_w.astype(f32) + lnx_b.astype(f32)
    o = o + (bonuses[0] + bonuses[1]).reshape(b, l, d)
    y = (o * g.astype(f32)).astype(h.dtype) @ wo
    return y, finals[0], finals[1]


def run_trunk(x, cond, s0_fwd, s0_bwd, p):
    new_fwd, new_bwd = [], []
    for i in range(DEPTH):
        kind, j = i % N_MIXERS, i // N_MIXERS
        mod = jax.nn.silu(cond) @ p['ada_w'][i] + p['ada_b'][i]
        sh1, sc1, gt1, sh2, sc2, gt2 = jnp.split(mod[:, None, :], 6, axis=-1)
        ng = p['norm_g'][i]
        h = rms_norm(x, ng[0]) * (1 + sc1) + sh1
        if kind == 0:
            y = fourier_mixer(h, p['fn_w_out'][j], p['fn_b_out'][j])
        elif kind == 1:
            y = hyena_mixer(h, p['hy_w_in'][j], p['hy_b_in'][j], p['hy_conv_w'][j], p['hy_conv_b'][j],
                            p['hy_f_w1'][j], p['hy_f_b1'][j], p['hy_f_freq'][j], p['hy_f_w2'][j],
                            p['hy_f_b2'][j], p['hy_f_w3'][j], p['hy_d'][j], p['hy_w_out'][j], p['hy_b_out'][j])
        else:
            y, sf, sb = rwkv7_mixer(h, s0_fwd[:, j], s0_bwd[:, j], p['rw_mix'][j], p['rw_wr'][j],
                                    p['rw_wk'][j], p['rw_wv'][j], p['rw_wo'][j], p['rw_w0'][j],
                                    p['rw_w1'][j], p['rw_w2'][j], p['rw_a0'][j], p['rw_a1'][j],
                                    p['rw_a2'][j], p['rw_g1'][j], p['rw_g2'][j], p['rw_kk'][j],
                                    p['rw_ka'][j], p['rw_rk'][j], p['rw_lnx_w'][j], p['rw_lnx_b'][j])
            new_fwd.append(sf)
            new_bwd.append(sb)
        x = x + gt1 * rms_norm(y.astype(x.dtype), ng[1])
        h = rms_norm(x, ng[2]) * (1 + sc2) + sh2
        y = swiglu(h, p['ffn_w1'][i], p['ffn_w3'][i], p['ffn_w2'][i])
        x = x + gt2 * rms_norm(y.astype(x.dtype), ng[3])
    return x, jnp.stack(new_fwd, axis=1), jnp.stack(new_bwd, axis=1)


def setup_inputs(seed: int = 0) -> dict:
    key = jax.random.key(seed)
    ks = iter(jax.random.split(key, 64))
    f32 = jnp.float32

    def nrm(shape, s):
        return jax.random.normal(next(ks), shape, f32) * s

    def uni(shape, lo, hi):
        return jax.random.uniform(next(ks), shape, f32, lo, hi)

    D, F, H, N = D_MODEL, D_FF, RW_HEADS, RW_HEAD
    nA, nB, nC = (_n_layers_of_kind(kd) for kd in range(N_MIXERS))
    return {
        'x_prompt': nrm((BATCH, SEQ, D), 1.0),
        'x_sample': nrm((DEC_BATCH, DEC_SEQ, D), 1.0),
        'state_wkv_fwd': nrm((DEC_BATCH, nC, H, N, N), 0.5),
        'state_wkv_bwd': nrm((DEC_BATCH, nC, H, N, N), 0.5),
        'c': nrm((DEC_BATCH, D), 1.0),
        'c_ctx': nrm((D,), 1.0),
        'ada_w': nrm((DEPTH, D, 6 * D), 0.5 * D ** -0.5),
        'ada_b': nrm((DEPTH, 6 * D), 0.02),
        'norm_g': 1.0 + nrm((DEPTH, 4, D), 0.02),
        'ffn_w1': nrm((DEPTH, D, F), D ** -0.5),
        'ffn_w3': nrm((DEPTH, D, F), D ** -0.5),
        'ffn_w2': nrm((DEPTH, F, D), F ** -0.5),
        'fn_w_out': nrm((nA, D, D), D ** -0.5),
        'fn_b_out': nrm((nA, D), 0.02),
        'hy_w_in': nrm((nB, D, HY_PROJ * D), D ** -0.5),
        'hy_b_in': nrm((nB, HY_PROJ * D), 0.02),
        'hy_conv_w': nrm((nB, 3, HY_PROJ * D), 3 ** -0.5),
        'hy_conv_b': nrm((nB, HY_PROJ * D), 0.02),
        'hy_f_w1': nrm((nB, HY_EMB, HY_FILT), HY_EMB ** -0.5),
        'hy_f_b1': nrm((nB, HY_FILT), 0.02),
        'hy_f_freq': 1.0 + nrm((nB, 2, HY_FILT), 0.1),
        'hy_f_w2': nrm((nB, HY_FILT, HY_FILT), HY_FILT ** -0.5),
        'hy_f_b2': nrm((nB, HY_FILT), 0.02),
        'hy_f_w3': nrm((nB, HY_FILT, 2 * D), HY_FILT ** -0.5),
        'hy_d': nrm((nB, D), 1.0),
        'hy_w_out': nrm((nB, D, D), D ** -0.5),
        'hy_b_out': nrm((nB, D), 0.02),
        'rw_mix': uni((nC, 6, D), 0.0, 1.0),
        'rw_wr': nrm((nC, D, D), D ** -0.5),
        'rw_wk': nrm((nC, D, D), D ** -0.5),
        'rw_wv': nrm((nC, D, D), D ** -0.5),
        'rw_wo': nrm((nC, D, D), D ** -0.5),
        'rw_w0': uni((nC, 2, D), -6.0, -1.0),
        'rw_w1': nrm((nC, 2, D, RW_DECAY_LORA), 0.1 * D ** -0.5),
        'rw_w2': nrm((nC, 2, RW_DECAY_LORA, D), 0.1 * RW_DECAY_LORA ** -0.5),
        'rw_a0': nrm((nC, 2, D), 0.1),
        'rw_a1': nrm((nC, 2, D, RW_AAA_LORA), 0.1 * D ** -0.5),
        'rw_a2': nrm((nC, 2, RW_AAA_LORA, D), 0.1 * RW_AAA_LORA ** -0.5),
        'rw_g1': nrm((nC, D, RW_GATE_LORA), D ** -0.5),
        'rw_g2': nrm((nC, RW_GATE_LORA, D), RW_GATE_LORA ** -0.5),
        'rw_kk': 0.85 + nrm((nC, D), 0.02),
        'rw_ka': 1.0 + nrm((nC, D), 0.02),
        'rw_rk': nrm((nC, H, N), 0.1),
        'rw_lnx_w': 1.0 + nrm((nC, D), 0.02),
        'rw_lnx_b': nrm((nC, D), 0.02),
    }


def reference(x_prompt, x_sample, state_wkv_fwd, state_wkv_bwd, c, c_ctx,
              ada_w, ada_b, norm_g, ffn_w1, ffn_w3, ffn_w2, fn_w_out, fn_b_out,
              hy_w_in, hy_b_in, hy_conv_w, hy_conv_b, hy_f_w1, hy_f_b1, hy_f_freq,
              hy_f_w2, hy_f_b2, hy_f_w3, hy_d, hy_w_out, hy_b_out,
              rw_mix, rw_wr, rw_wk, rw_wv, rw_wo, rw_w0, rw_w1, rw_w2, rw_a0, rw_a1, rw_a2,
              rw_g1, rw_g2, rw_kk, rw_ka, rw_rk, rw_lnx_w, rw_lnx_b):
    p = {
        'ada_w': ada_w, 'ada_b': ada_b, 'norm_g': norm_g,
        'ffn_w1': ffn_w1, 'ffn_w3': ffn_w3, 'ffn_w2': ffn_w2,
        'fn_w_out': fn_w_out, 'fn_b_out': fn_b_out,
        'hy_w_in': hy_w_in, 'hy_b_in': hy_b_in, 'hy_conv_w': hy_conv_w, 'hy_conv_b': hy_conv_b,
        'hy_f_w1': hy_f_w1, 'hy_f_b1': hy_f_b1, 'hy_f_freq': hy_f_freq, 'hy_f_w2': hy_f_w2,
        'hy_f_b2': hy_f_b2, 'hy_f_w3': hy_f_w3, 'hy_d': hy_d, 'hy_w_out': hy_w_out, 'hy_b_out': hy_b_out,
        'rw_mix': rw_mix, 'rw_wr': rw_wr, 'rw_wk': rw_wk, 'rw_wv': rw_wv, 'rw_wo': rw_wo,
        'rw_w0': rw_w0, 'rw_w1': rw_w1, 'rw_w2': rw_w2, 'rw_a0': rw_a0, 'rw_a1': rw_a1, 'rw_a2': rw_a2,
        'rw_g1': rw_g1, 'rw_g2': rw_g2, 'rw_kk': rw_kk, 'rw_ka': rw_ka, 'rw_rk': rw_rk,
        'rw_lnx_w': rw_lnx_w, 'rw_lnx_b': rw_lnx_b,
    }
    n_rwkv = rw_w0.shape[0]
    zeros = jnp.zeros((x_prompt.shape[0], n_rwkv, RW_HEADS, RW_HEAD, RW_HEAD), jnp.float32)
    y_prompt, new_state_wkv_fwd, new_state_wkv_bwd = run_trunk(x_prompt, c_ctx[None, :], zeros, zeros, p)
    y_sample, _, _ = run_trunk(x_sample, c, state_wkv_fwd, state_wkv_bwd, p)
    return (y_prompt, y_sample, new_state_wkv_fwd, new_state_wkv_bwd)
```

```cpp
#include <hip/hip_runtime.h>
#include <hip/hip_cooperative_groups.h>
#include <cstdio>
#include <cstdint>
namespace cg = cooperative_groups;

#define LAS __attribute__((address_space(3)))
typedef unsigned short bf16_t;
typedef short bf16x8 __attribute__((ext_vector_type(8)));
typedef float f32x4 __attribute__((ext_vector_type(4)));
typedef float f32x2 __attribute__((ext_vector_type(2)));
typedef unsigned u32x4 __attribute__((ext_vector_type(4)));
typedef unsigned u32x2 __attribute__((ext_vector_type(2)));

constexpr int T_TOK = 12288, DM = 1024, FF = 2816;
constexpr int NTHR = 512, NWAVES = 8;
constexpr int LDS_BYTES = 147456;

constexpr size_t SZ_TD2 = (size_t)T_TOK * DM * 2;
constexpr size_t WS_MOD = 4096;
constexpr size_t WS_BIAS = WS_MOD + 491520;
constexpr size_t WS_W13T = WS_BIAS + 40960;
constexpr size_t WS_W2T = WS_W13T + (size_t)5632 * 1024 * 2;
constexpr size_t WS_FNWT = WS_W2T + (size_t)1024 * 2816 * 2;
constexpr size_t WS_HYWINT = WS_FNWT + 2 * 2097152;
constexpr size_t WS_HYWOUTT = WS_HYWINT + 6291456;
constexpr size_t WS_RWT = WS_HYWOUTT + 2097152;
constexpr size_t WS_LORA1T = WS_RWT + 6291456;
constexpr size_t WS_WOT = WS_LORA1T + 1572864;
constexpr size_t WS_LORA2T = WS_WOT + 2097152;
constexpr size_t WS_CS256 = WS_LORA2T + 2621440;
constexpr size_t WS_SEQ256 = WS_CS256 + 262144;
constexpr size_t WS_SEQ2048 = WS_SEQ256 + 262144;
constexpr size_t WS_X = WS_SEQ2048 + 16777216;
constexpr size_t WS_H = WS_X + (size_t)T_TOK * DM * 4;
constexpr size_t WS_L1 = WS_H + SZ_TD2;
constexpr size_t WS_Y = WS_L1 + (size_t)T_TOK * 384 * 2;
constexpr size_t WS_S1 = WS_Y + SZ_TD2;
constexpr size_t WS_S2 = WS_S1 + 6 * SZ_TD2;
constexpr size_t WS_END = WS_S2 + 3 * SZ_TD2;
constexpr size_t WS_TB = WS_S1;
constexpr size_t WS_HCST = WS_S1;
constexpr size_t WS_FOUT = WS_S1 + 2 * SZ_TD2;
constexpr size_t WS_UT = WS_S1;
constexpr size_t WS_YO = WS_S1 + 3 * SZ_TD2;
constexpr size_t WS_KF2048 = WS_S2;
constexpr size_t WS_KF256 = WS_S2 + 16777216;
constexpr size_t WS_XM = WS_S1;
constexpr size_t WS_RKV = WS_S2;
constexpr size_t WS_G = WS_S1;
constexpr size_t WS_E = WS_S1 + SZ_TD2;
constexpr size_t WS_AA = WS_S1 + 3 * SZ_TD2;
constexpr size_t WS_OF = WS_S1 + 5 * SZ_TD2;
constexpr size_t WS_OB = WS_H;

struct Params { const float* in[45]; float* out; unsigned char* ws; };
typedef const float* const __attribute__((address_space(4)))* kin_t;
struct KP { kin_t k;
    __device__ __forceinline__ const float* in(int i) const { return k[i]; }
    __device__ __forceinline__ float* out() const { return (float*)k[45]; }
    __device__ __forceinline__ unsigned char* ws() const { return (unsigned char*)k[46]; } };

enum { I_XP = 0, I_XS, I_SF, I_SB, I_C, I_CCTX, I_ADAW, I_ADAB, I_NG, I_W1, I_W3, I_W2, I_FNW, I_FNB, I_HYWIN, I_HYBIN, I_HYCW, I_HYCB,
       I_HYFW1, I_HYFB1, I_HYFREQ, I_HYFW2, I_HYFB2, I_HYFW3, I_HYD, I_HYWOUT, I_HYBOUT, I_MIX, I_WR, I_WK, I_WV, I_WO, I_W0, I_RW1, I_RW2,
       I_A0, I_A1, I_A2, I_G1, I_G2, I_KK, I_KA, I_RK, I_LNW, I_LNB };

__device__ __forceinline__ unsigned cvt_pk_bf16(float lo, float hi) { unsigned r; asm volatile("v_cvt_pk_bf16_f32 %0, %1, %2" : "=v"(r) : "v"(lo), "v"(hi)); return r; }
__device__ __forceinline__ float bf2f(unsigned short b) { return __builtin_bit_cast(float, (unsigned)b << 16); }
__device__ __forceinline__ float bflo(unsigned w) { return __builtin_bit_cast(float, w << 16); }
__device__ __forceinline__ float bfhi(unsigned w) { return __builtin_bit_cast(float, w & 0xffff0000u); }
template <int CTRL> __device__ __forceinline__ float dpp_f(float v) { return __builtin_bit_cast(float, __builtin_amdgcn_mov_dpp(__builtin_bit_cast(int, v), CTRL, 0xf, 0xf, true)); }
__device__ __forceinline__ float sum4(float v) { v += dpp_f<0xB1>(v); v += dpp_f<0x4E>(v); return v; }
__device__ __forceinline__ float sum8(float v) { v = sum4(v); v += dpp_f<0x141>(v); return v; }
__device__ __forceinline__ float sum16(float v) { v = sum8(v); v += dpp_f<0x140>(v); return v; }
__device__ __forceinline__ float wave_sum(float v) {
    v = sum16(v);
    const int iv = __builtin_bit_cast(int, v);
    return (__builtin_bit_cast(float, __builtin_amdgcn_readlane(iv, 0)) + __builtin_bit_cast(float, __builtin_amdgcn_readlane(iv, 16)))
         + (__builtin_bit_cast(float, __builtin_amdgcn_readlane(iv, 32)) + __builtin_bit_cast(float, __builtin_amdgcn_readlane(iv, 48)));
}
__device__ __forceinline__ int cond_of(int r) { return r < 4096 ? 0 : 1 + ((r - 4096) >> 11); }
__device__ __forceinline__ void tile_seq(int tt, int& start, int& L, int& l0) {
    if (tt < 16) { start = tt * 256; L = 256; l0 = 0; } else { const int j = (tt - 16) >> 3; start = 4096 + j * 2048; L = 2048; l0 = ((tt - 16) & 7) * 256; }
}
__device__ __forceinline__ float sigmoidf_(float x) { return __builtin_amdgcn_rcpf(1.f + __expf(-x)); }

constexpr int BK = 64, HALF = 128, HTB = HALF * BK * 2;
__device__ __forceinline__ int lds_byte(int r, int c) { const int st = (r >> 4) * 2 + (c >> 5), rr = r & 15, cc = c & 31, ob = rr * 64 + cc * 2; return st * 1024 + (ob ^ (((ob >> 9) & 1) << 5)); }
__device__ __forceinline__ void stage_rc(int b, int& R, int& C) { const int st = b / 1024, sb = b % 1024, swz = sb ^ (((sb >> 9) & 1) << 5); R = (st >> 1) * 16 + swz / 64; C = (st & 1) * 32 + (swz % 64) / 2; }

struct Unit { const char* A; const char* B; char* O; const float* bcol; const float* brow; int ldc; int mode; };
enum { EM_PLAIN = 0, EM_SWIGLU = 1, EM_TANH128 = 2, EM_SIG128 = 3, EM_ID128 = 4, EM_DECAY = 5, EM_SIGB = 6 };

struct EpiGen {
    __device__ __forceinline__ void operator()(const f32x4 (&acc)[2][2][4][2], const Unit& u, int wr, int wc, int fr, int fq) const {
        bf16_t* O = (bf16_t*)u.O; const int ldc = u.ldc, mode = u.mode;
        if (mode == EM_SWIGLU) {
#pragma unroll
            for (int ai = 0; ai < 2; ++ai)
#pragma unroll
                for (int m = 0; m < 4; ++m) {
                    const int row = ai * HALF + wr * 64 + m * 16 + fr;
#pragma unroll
                    for (int bj = 0; bj < 2; ++bj) {
                        const f32x4 a = acc[ai][bj][m][0], b = acc[ai][bj][m][1]; f32x4 o;
#pragma unroll
                        for (int e = 0; e < 4; ++e) o[e] = a[e] * sigmoidf_(a[e]) * b[e];
                        u32x2 w; w.x = cvt_pk_bf16(o[0], o[1]); w.y = cvt_pk_bf16(o[2], o[3]);
                        *(u32x2*)(O + (size_t)row * ldc + bj * 64 + wc * 16 + fq * 4) = w;
                    }
                }
            return;
        }
        const bool half_only = (mode == EM_TANH128 || mode == EM_SIG128 || mode == EM_ID128);
#pragma unroll
        for (int ai = 0; ai < 2; ++ai)
#pragma unroll
            for (int m = 0; m < 4; ++m) {
                const int row = ai * HALF + wr * 64 + m * 16 + fr;
                const float br = u.brow ? u.brow[row] : 0.f;
#pragma unroll
                for (int bj = 0; bj < 2; ++bj) {
                    if (half_only && bj == 1) continue;
#pragma unroll
                    for (int n = 0; n < 2; ++n) {
                        const int col = bj * HALF + wc * 32 + n * 16 + fq * 4;
                        f32x4 v = acc[ai][bj][m][n];
                        if (u.bcol) v += *(const f32x4*)(u.bcol + col);
                        v += br;
                        if (mode == EM_TANH128) {
#pragma unroll
                            for (int e = 0; e < 4; ++e) v[e] = 1.f - 2.f * __builtin_amdgcn_rcpf(1.f + __expf(2.f * v[e]));
                        } else if (mode == EM_SIG128 || mode == EM_SIGB) {
#pragma unroll
                            for (int e = 0; e < 4; ++e) v[e] = sigmoidf_(v[e]);
                        } else if (mode == EM_DECAY) {
#pragma unroll
                            for (int e = 0; e < 4; ++e) v[e] = 0.60653066f * sigmoidf_(v[e]);
                        }
                        u32x2 w; w.x = cvt_pk_bf16(v[0], v[1]); w.y = cvt_pk_bf16(v[2], v[3]);
                        *(u32x2*)(O + (size_t)row * ldc + col) = w;
                    }
                }
            }
    }
};

template <bool ALIGN_EPI, class Sched, class Epi>
__device__ __forceinline__ void gemm_phase(const int tid, LAS unsigned char* lds, const int lda, const int ldb, const int nt, const Sched& S, const Epi& E) {
    const int wid = __builtin_amdgcn_readfirstlane(tid >> 6), lane = tid & 63, wr = wid >> 2, wc = wid & 3, fr = lane & 15, fq = lane >> 4;
    unsigned voffA[2], voffB[2];
#pragma unroll
    for (int i = 0; i < 2; ++i) { int R, C; stage_rc(tid * 16 + i * 8192, R, C); voffA[i] = (unsigned)(R * lda + C) * 2u; voffB[i] = (unsigned)(R * ldb + C) * 2u; }
    const size_t kstep = (size_t)(BK * 2);
    const size_t hstepA = (size_t)HALF * lda * 2, hstepB = (size_t)HALF * ldb * 2;
    const unsigned ldsw = (unsigned)wid * 1024u;
    const int aoff = lds_byte(wr * 64 + fr, fq * 8), boff = lds_byte(wc * 32 + fr, fq * 8);
#define PG8_SA(b, h) (((b) * 2 + (h)) * HTB)
#define PG8_SB(b, h) ((4 + (b) * 2 + (h)) * HTB)
#define PG8_STAGE(bufoff, gbase, voff) do { _Pragma("unroll") for (int _i = 0; _i < 2; ++_i) \
        __builtin_amdgcn_global_load_lds((const unsigned*)((const char*)(gbase) + (voff)[_i]), (LAS unsigned*)(lds + (bufoff) + ldsw + _i * 8192), 16, 0, 0); } while (0)
#define PG8_LDA(dst, b, h) do { _Pragma("unroll") for (int m = 0; m < 4; ++m) _Pragma("unroll") for (int k = 0; k < 2; ++k) dst[m][k] = *(const LAS bf16x8*)(lds + PG8_SA(b, h) + aoff + m * 2048 + k * 1024); } while (0)
#define PG8_LDB(dst, b, h) do { _Pragma("unroll") for (int n = 0; n < 2; ++n) _Pragma("unroll") for (int k = 0; k < 2; ++k) dst[n][k] = *(const LAS bf16x8*)(lds + PG8_SB(b, h) + boff + n * 2048 + k * 1024); } while (0)
#define PG8_MMA(ai, bj, At, Bt) do { __builtin_amdgcn_s_setprio(1); _Pragma("unroll") for (int m = 0; m < 4; ++m) _Pragma("unroll") for (int n = 0; n < 2; ++n) _Pragma("unroll") for (int k = 0; k < 2; ++k) \
        acc[ai][bj][m][n] = __builtin_amdgcn_mfma_f32_16x16x32_bf16(Bt[n][k], At[m][k], acc[ai][bj][m][n], 0, 0, 0); __builtin_amdgcn_s_setprio(0); } while (0)
#define PG8_WAIT_V(n) asm volatile("s_waitcnt vmcnt(" #n ")" ::: "memory")
#define PG8_WAIT_L(n) asm volatile("s_waitcnt lgkmcnt(" #n ")" ::: "memory")
#define PG8_BAR __builtin_amdgcn_s_barrier()
#define PG8_SCHED __builtin_amdgcn_sched_barrier(0)
    Unit cur, nxt; int ui = 0;
    if (!S.next(0, cur)) return;
    f32x4 acc[2][2][4][2];
#pragma unroll
    for (int a = 0; a < 2; ++a)
#pragma unroll
        for (int b = 0; b < 2; ++b)
#pragma unroll
            for (int m = 0; m < 4; ++m)
#pragma unroll
                for (int n = 0; n < 2; ++n) acc[a][b][m][n] = (f32x4){0.f, 0.f, 0.f, 0.f};
    bf16x8 At[4][2], B0[2][2], B1[2][2];
    const char* cA = cur.A; const char* cB = cur.B;
    PG8_STAGE(PG8_SB(0, 0), cB, voffB); PG8_STAGE(PG8_SB(0, 1), cB + hstepB, voffB); PG8_STAGE(PG8_SA(0, 0), cA, voffA); PG8_STAGE(PG8_SA(0, 1), cA + hstepA, voffA);
    if (wr == 1) PG8_BAR;
    PG8_WAIT_V(2); PG8_BAR;
    PG8_STAGE(PG8_SB(1, 0), cB + kstep, voffB); PG8_STAGE(PG8_SA(1, 0), cA + kstep, voffA); PG8_STAGE(PG8_SB(1, 1), cB + hstepB + kstep, voffB);
    PG8_WAIT_V(6); PG8_BAR;
    for (;;) {
        const bool has_next = S.next(ui + 1, nxt);
        const char* nA = has_next ? nxt.A : cA; const char* nB = has_next ? nxt.B : cB;
        for (int t = 0; t < nt; t += 2) {
            const bool last = (t == nt - 2);
            const char* a1 = cA + (size_t)(t + 1) * kstep;
            const char* a2 = last ? nA : cA + (size_t)(t + 2) * kstep; const char* b2 = last ? nB : cB + (size_t)(t + 2) * kstep;
            const char* a3 = a2 + kstep; const char* b3 = b2 + kstep;
            PG8_LDB(B0, 0, 0); PG8_LDB(B1, 0, 1); PG8_SCHED; PG8_LDA(At, 0, 0); PG8_STAGE(PG8_SA(1, 1), a1 + hstepA, voffA);
            PG8_WAIT_V(8); PG8_WAIT_L(0); PG8_BAR; PG8_MMA(0, 0, At, B0); PG8_MMA(0, 1, At, B1); PG8_BAR; PG8_SCHED;
            PG8_LDA(At, 0, 1); PG8_STAGE(PG8_SB(0, 0), b2, voffB); PG8_STAGE(PG8_SB(0, 1), b2 + hstepB, voffB); PG8_STAGE(PG8_SA(0, 0), a2, voffA);
            PG8_WAIT_V(8); PG8_WAIT_L(0); PG8_BAR; PG8_MMA(1, 0, At, B0); PG8_MMA(1, 1, At, B1); PG8_BAR; PG8_SCHED;
            PG8_LDB(B0, 1, 0); PG8_LDB(B1, 1, 1); PG8_SCHED; PG8_LDA(At, 1, 0); PG8_STAGE(PG8_SA(0, 1), a2 + hstepA, voffA);
            PG8_WAIT_V(8); PG8_WAIT_L(0); PG8_BAR; PG8_MMA(0, 0, At, B0); PG8_MMA(0, 1, At, B1); PG8_BAR; PG8_SCHED;
            PG8_LDA(At, 1, 1); PG8_STAGE(PG8_SB(1, 0), b3, voffB); PG8_STAGE(PG8_SB(1, 1), b3 + hstepB, voffB); PG8_STAGE(PG8_SA(1, 0), a3, voffA);
            PG8_WAIT_V(8); PG8_WAIT_L(0); PG8_BAR; PG8_MMA(1, 0, At, B0); PG8_MMA(1, 1, At, B1); PG8_BAR; PG8_SCHED;
        }
        if constexpr (ALIGN_EPI) { if (wr == 0) PG8_BAR; }
        { Unit eu; (void)S.next(ui, eu); E(acc, eu, wr, wc, fr, fq); }
        if (!has_next) break;
#pragma unroll
        for (int a = 0; a < 2; ++a)
#pragma unroll
            for (int b = 0; b < 2; ++b)
#pragma unroll
                for (int m = 0; m < 4; ++m)
#pragma unroll
                    for (int n = 0; n < 2; ++n) acc[a][b][m][n] = (f32x4){0.f, 0.f, 0.f, 0.f};
        cur = nxt; cA = nA; cB = nB; ++ui;
        if constexpr (ALIGN_EPI) { if (wr == 1) PG8_BAR; }
    }
    PG8_WAIT_V(0);
    if constexpr (!ALIGN_EPI) { if (wr == 0) PG8_BAR; }
    PG8_BAR;
#undef PG8_SA
#undef PG8_SB
#undef PG8_STAGE
#undef PG8_LDA
#undef PG8_LDB
#undef PG8_MMA
#undef PG8_WAIT_V
#undef PG8_WAIT_L
#undef PG8_BAR
#undef PG8_SCHED
}

enum { PH_PREP = 0, PH_R0 = 1, PH_RMID = 2, PH_REND = 3, PH_HC = 4, PH_RS = 5, PH_RP = 6,
       PH_FG1 = 8, PH_FG2S = 9, PH_FG2P = 10, PH_FG3 = 11, PH_HG1 = 12, PH_HG2 = 13, PH_RG1 = 14, PH_RG2 = 15, PH_RG3 = 16, PH_NG1 = 17, PH_NG2 = 18 };
struct SchedAny {
    int code, l, G, c; unsigned char* ws;
    __device__ __forceinline__ bool next(int i, Unit& u) const {
        int L = i * G + c; const char* w = (const char*)ws; const float* bias = (const float*)(ws + WS_BIAS);
        u.bcol = nullptr; u.brow = nullptr; u.mode = EM_PLAIN; u.ldc = 1024;
        switch (code) {
        case PH_FG1: {
            if (L >= 384) return false;
            const int tt = L >> 3, rem = L & 7, g = rem >> 1, pm = rem & 1; int start, Ls, l0; tile_seq(tt, start, Ls, l0);
            u.A = w + WS_CS256 + (size_t)pm * 256 * 256 * 2; u.B = w + WS_H + ((size_t)tt * 256 * 1024 + g * 256) * 2;
            u.O = (char*)ws + WS_HCST + ((size_t)start * 2048 + (size_t)(g * 512 + pm * 256) * Ls + l0) * 2; u.ldc = Ls; return true; }
        case PH_FG2S: {
            if (L >= 128) return false;
            const int j = L >> 5, rem = L & 31, pm = rem >> 2, pn = rem & 3; const size_t start = 4096 + (size_t)j * 2048;
            u.A = w + WS_SEQ2048 + (size_t)pm * 256 * 4096 * 2; u.B = w + WS_HCST + (start * 2048 + (size_t)pn * 256 * 4096) * 2;
            u.O = (char*)ws + WS_FOUT + ((start + pm * 256) * 1024 + pn * 256) * 2; return true; }
        case PH_FG2P: {
            const int cc = (c + G - (128 % G)) % G; L = i * G + cc; if (L >= 64) return false;
            const int s = L >> 2, pn = L & 3;
            u.A = w + WS_SEQ256; u.B = w + WS_HCST + ((size_t)s * 256 * 2048 + (size_t)pn * 256 * 512) * 2;
            u.O = (char*)ws + WS_FOUT + ((size_t)s * 256 * 1024 + pn * 256) * 2; return true; }
        case PH_HG1: {
            if (L >= 576) return false;
            const int tt = L / 12, pm = L - tt * 12; int start, Ls, l0; tile_seq(tt, start, Ls, l0);
            u.A = w + WS_HYWINT + (size_t)pm * 256 * 1024 * 2; u.B = w + WS_H + (size_t)tt * 256 * 1024 * 2;
            u.O = (char*)ws + WS_UT + ((size_t)start * 3072 + (size_t)pm * 256 * Ls + l0) * 2; u.ldc = Ls; u.brow = bias + 2048 + pm * 256; return true; }
        case PH_RG1: {
            if (L >= 720) return false;
            if (L < 576) { const int p = L / 192, r = L - p * 192, pm = r >> 2, pn = r & 3;
                u.A = w + WS_XM + (size_t)p * SZ_TD2 + (size_t)pm * 256 * 1024 * 2; u.B = w + WS_RWT + ((size_t)p * 1024 + pn * 256) * 1024 * 2;
                u.O = (char*)ws + WS_RKV + (size_t)p * SZ_TD2 + ((size_t)pm * 256 * 1024 + pn * 256) * 2;
            } else { const int q = L - 576, p = q / 48, pm = q - p * 48;
                u.A = w + WS_XM + (size_t)(3 + p) * SZ_TD2 + (size_t)pm * 256 * 1024 * 2; u.B = w + WS_LORA1T + (size_t)p * 256 * 1024 * 2;
                u.O = (char*)ws + WS_L1 + ((size_t)pm * 256 * 384 + p * 128) * 2; u.ldc = 384; u.mode = (p == 0) ? EM_TANH128 : (p == 1 ? EM_ID128 : EM_SIG128); }
            return true; }
        case PH_RG2: {
            if (L >= 960) return false;
            const int p = L / 192, r = L - p * 192, pm = r >> 2, pn = r & 3;
            u.A = w + WS_L1 + ((size_t)pm * 256 * 384 + (p == 4 ? 128 : 0)) * 2; u.B = w + WS_LORA2T + ((size_t)p * 1024 + pn * 256) * 256 * 2;
            const size_t o = ((size_t)pm * 256 * 1024 + pn * 256) * 2;
            if (p == 4) { u.O = (char*)ws + WS_G + o; }
            else if (p < 2) { u.O = (char*)ws + WS_E + (size_t)p * SZ_TD2 + o; u.bcol = bias + 6144 + p * 1024 + pn * 256; u.mode = EM_DECAY; }
            else { u.O = (char*)ws + WS_AA + (size_t)(p - 2) * SZ_TD2 + o; u.bcol = bias + 8192 + (p - 2) * 1024 + pn * 256; u.mode = EM_SIGB; }
            return true; }
        case PH_NG1: {
            if (L >= 1056) return false;
            const int pm = L / 22, pn = L - pm * 22;
            u.A = w + WS_H + (size_t)pm * 256 * 1024 * 2; u.B = w + WS_W13T + (size_t)pn * 256 * 1024 * 2;
            u.O = (char*)ws + WS_TB + ((size_t)pm * 256 * FF + pn * 128) * 2; u.ldc = FF; u.mode = EM_SWIGLU; return true; }
        default: {
            if (L >= 192) return false;
            const int pm = L >> 2, pn = L & 3; size_t a, b, k;
            if (code == PH_FG3) { a = WS_FOUT; b = WS_FNWT + (size_t)(l / 3) * 2097152; k = 1024; u.bcol = bias + (l / 3) * 1024 + pn * 256; }
            else if (code == PH_HG2) { a = WS_YO; b = WS_HYWOUTT; k = 1024; u.bcol = bias + 5120 + pn * 256; }
            else if (code == PH_RG3) { a = WS_OF; b = WS_WOT; k = 1024; }
            else { a = WS_TB; b = WS_W2T; k = FF; }
            u.A = w + a + (size_t)pm * 256 * k * 2; u.B = w + b + (size_t)pn * 256 * k * 2;
            u.O = (char*)ws + WS_Y + ((size_t)pm * 256 * 1024 + pn * 256) * 2; return true; }
        }
    }
};

__device__ __forceinline__ void transpose_item(const float* W, int N, bf16_t* WT, int dst_ld, int k_off, int mode, int row_off, LAS float* scr, int item, int lane) {
    const int nblk = N / 32, kb = item / nblk, nb = item - kb * nblk, k0 = 64 * kb, n0 = 32 * nb;
#pragma unroll 8
    for (int i = 0; i < 32; ++i) { const int kk = 2 * i + (lane >> 5); scr[kk * 33 + (lane & 31)] = W[(size_t)(k0 + kk) * N + n0 + (lane & 31)]; }
    asm volatile("s_waitcnt lgkmcnt(0)" ::: "memory");
    const int c = lane & 7;
#pragma unroll
    for (int j = 0; j < 4; ++j) { const int n = (lane >> 3) + 8 * j; const LAS float* s = scr + (8 * c) * 33 + n; const int nn = n0 + n;
        const int drow = (mode == 0) ? row_off + nn : ((nn >> 4) * 32 + (nn & 15) + (mode == 2 ? 16 : 0));
        u32x4 o; o.x = cvt_pk_bf16(s[0 * 33], s[1 * 33]); o.y = cvt_pk_bf16(s[2 * 33], s[3 * 33]); o.z = cvt_pk_bf16(s[4 * 33], s[5 * 33]); o.w = cvt_pk_bf16(s[6 * 33], s[7 * 33]);
        *(u32x4*)(WT + (size_t)drow * dst_ld + k_off + k0 + 8 * c) = o; }
    asm volatile("s_waitcnt lgkmcnt(0)" ::: "memory");
}

__device__ __forceinline__ void convert_ffn(const KP& p, int l, LAS float* scr, int gw, int NGW, int lane) {
    const float* w1 = p.in(I_W1) + (size_t)l * DM * FF; const float* w3 = p.in(I_W3) + (size_t)l * DM * FF; const float* w2 = p.in(I_W2) + (size_t)l * FF * DM;
    bf16_t* w13t = (bf16_t*)(p.ws() + WS_W13T); bf16_t* w2t = (bf16_t*)(p.ws() + WS_W2T);
    for (int it = gw; it < 4224; it += NGW) {
        int r = it;
        if (r < 1408) { transpose_item(w1, FF, w13t, 1024, 0, 1, 0, scr, r, lane); continue; } r -= 1408;
        if (r < 1408) { transpose_item(w3, FF, w13t, 1024, 0, 2, 0, scr, r, lane); continue; } r -= 1408;
        transpose_item(w2, DM, w2t, FF, 0, 0, 0, scr, r, lane);
    }
}

__device__ __forceinline__ void p0_transposes(const KP& p, LAS float* scr, int gw, int NGW, int lane) {
    unsigned char* ws = p.ws();
    for (int it = gw; it < 5504; it += NGW) {
        int r = it;
        if (r < 1024) { const int j = r >> 9; transpose_item(p.in(I_FNW) + (size_t)j * DM * DM, DM, (bf16_t*)(ws + WS_FNWT) + (size_t)j * DM * DM, 1024, 0, 0, 0, scr, r & 511, lane); continue; } r -= 1024;
        if (r < 1536) { transpose_item(p.in(I_HYWIN), 3072, (bf16_t*)(ws + WS_HYWINT), 1024, 0, 0, 0, scr, r, lane); continue; } r -= 1536;
        if (r < 512) { transpose_item(p.in(I_HYWOUT), DM, (bf16_t*)(ws + WS_HYWOUTT), 1024, 0, 0, 0, scr, r, lane); continue; } r -= 512;
        if (r < 1536) { const int j = r >> 9; transpose_item(p.in(I_WR + j), DM, (bf16_t*)(ws + WS_RWT) + (size_t)j * DM * DM, 1024, 0, 0, 0, scr, r & 511, lane); continue; } r -= 1536;
        if (r < 512) { transpose_item(p.in(I_WO), DM, (bf16_t*)(ws + WS_WOT), 1024, 0, 0, 0, scr, r, lane); continue; } r -= 512;
        if (r < 64) { const int d = r >> 5; transpose_item(p.in(I_RW1) + (size_t)d * DM * 64, 64, (bf16_t*)(ws + WS_LORA1T), 1024, 0, 0, d * 64, scr, r & 31, lane); continue; } r -= 64;
        if (r < 64) { const int d = r >> 5; transpose_item(p.in(I_A1) + (size_t)d * DM * 64, 64, (bf16_t*)(ws + WS_LORA1T) + 256 * 1024, 1024, 0, 0, d * 64, scr, r & 31, lane); continue; } r -= 64;
        if (r < 64) { transpose_item(p.in(I_G1), 128, (bf16_t*)(ws + WS_LORA1T) + 2 * 256 * 1024, 1024, 0, 0, 0, scr, r, lane); continue; } r -= 64;
        if (r < 64) { const int d = r >> 5; transpose_item(p.in(I_RW2) + (size_t)d * 64 * DM, DM, (bf16_t*)(ws + WS_LORA2T) + (size_t)d * 1024 * 256, 256, d * 64, 0, 0, scr, r & 31, lane); continue; } r -= 64;
        if (r < 64) { const int d = r >> 5; transpose_item(p.in(I_A2) + (size_t)d * 64 * DM, DM, (bf16_t*)(ws + WS_LORA2T) + (size_t)(2 + d) * 1024 * 256, 256, 128 + d * 64, 0, 0, scr, r & 31, lane); continue; } r -= 64;
        transpose_item(p.in(I_G2), DM, (bf16_t*)(ws + WS_LORA2T) + (size_t)4 * 1024 * 256, 256, 128, 0, 0, scr, r, lane);
    }
}

__device__ __forceinline__ void p0_tables(const KP& p, int gtid, int NT) {
    unsigned char* ws = p.ws();
    for (int it = gtid; it < 5 * 1024 * 32; it += NT) {
        const int m = it >> 15, rem = it & 32767, row = rem >> 5, ch = rem & 31, k = ch * 8;
        const int lo = (m == 0) ? 0 : (m == 1 ? 64 : (m == 2 ? 128 : (m == 3 ? 192 : 128))), hi = (m == 4) ? 256 : lo + 64;
        unsigned zz = 0u; asm volatile("" : "+v"(zz));
        if (k < lo || k >= hi) *(u32x4*)((bf16_t*)(ws + WS_LORA2T) + ((size_t)m * 1024 + row) * 256 + k) = (u32x4){zz, zz, zz, zz};
    }
    { float* bias = (float*)(ws + WS_BIAS);
      for (int it = gtid; it < 10240; it += NT) { float v;
          if (it < 2048) v = p.in(I_FNB)[it]; else if (it < 5120) v = p.in(I_HYBIN)[it - 2048]; else if (it < 6144) v = p.in(I_HYBOUT)[it - 5120]; else if (it < 8192) v = p.in(I_W0)[it - 6144]; else v = p.in(I_A0)[it - 8192];
          bias[it] = v; } }
    for (int it = gtid; it < 512 * 32; it += NT) {
        const int m = it >> 5, k0 = (it & 31) * 8, j = m >> 1, pp = m & 1; float v[8];
#pragma unroll
        for (int e = 0; e < 8; ++e) { const float fr = (float)((j * (k0 + e)) & 255) * (1.f / 256.f); v[e] = (pp ? __builtin_amdgcn_sinf(fr) : __builtin_amdgcn_cosf(fr)) * 0.0625f; }
        u32x4 o; o.x = cvt_pk_bf16(v[0], v[1]); o.y = cvt_pk_bf16(v[2], v[3]); o.z = cvt_pk_bf16(v[4], v[5]); o.w = cvt_pk_bf16(v[6], v[7]);
        *(u32x4*)((bf16_t*)(ws + WS_CS256) + (size_t)m * 256 + k0) = o;
    }
    for (int it = gtid; it < 256 * 64 + 2048 * 512; it += NT) {
        int L, lp, kc; bf16_t* dst;
        if (it < 256 * 64) { L = 256; lp = it >> 6; kc = (it & 63) * 8; dst = (bf16_t*)(ws + WS_SEQ256) + (size_t)lp * 512 + kc; }
        else { const int q = it - 256 * 64; L = 2048; lp = q >> 9; kc = (q & 511) * 8; dst = (bf16_t*)(ws + WS_SEQ2048) + (size_t)lp * 4096 + kc; }
        const int pp = kc >= L, l0 = kc - pp * L; const float invL = 1.f / (float)L, sc = (L == 256) ? 0.0625f : 0.022097087f; float v[8];
#pragma unroll
        for (int e = 0; e < 8; ++e) { const float fr = (float)((lp * (l0 + e)) & (L - 1)) * invL; v[e] = (pp ? -__builtin_amdgcn_sinf(fr) : __builtin_amdgcn_cosf(fr)) * sc; }
        u32x4 o; o.x = cvt_pk_bf16(v[0], v[1]); o.y = cvt_pk_bf16(v[2], v[3]); o.z = cvt_pk_bf16(v[4], v[5]); o.w = cvt_pk_bf16(v[6], v[7]);
        *(u32x4*)dst = o;
    }
}

__device__ __forceinline__ void p0_mod(const KP& p, const int tid, LAS float* lds_f, int c, int G) {
    LAS float* sc = lds_f;
    LAS float* part = lds_f + 5120;
    const int wid = tid >> 6, lane = tid & 63;
    for (int i = tid; i < 5120; i += NTHR) { const int cd = i >> 10, k = i & 1023; const float x = cd == 0 ? p.in(I_CCTX)[k] : p.in(I_C)[(cd - 1) * 1024 + k]; sc[i] = x * sigmoidf_(x); }
    __syncthreads();
    float* MOD = (float*)(p.ws() + WS_MOD);
    for (int it = c; it < 384; it += G) {
        const int l = it / 96, cg_ = it - l * 96, col = cg_ * 64 + lane;
        const float* W = p.in(I_ADAW) + (size_t)l * DM * 6144 + col;
        float a0 = 0.f, a1 = 0.f, a2 = 0.f, a3 = 0.f, a4 = 0.f;
        const int kb = wid * 128;
#pragma unroll 8
        for (int k = 0; k < 128; ++k) { const float w = W[(size_t)(kb + k) * 6144]; a0 += sc[kb + k] * w; a1 += sc[1024 + kb + k] * w; a2 += sc[2048 + kb + k] * w; a3 += sc[3072 + kb + k] * w; a4 += sc[4096 + kb + k] * w; }
        part[(wid * 5 + 0) * 64 + lane] = a0; part[(wid * 5 + 1) * 64 + lane] = a1; part[(wid * 5 + 2) * 64 + lane] = a2; part[(wid * 5 + 3) * 64 + lane] = a3; part[(wid * 5 + 4) * 64 + lane] = a4;
        __syncthreads();
        if (tid < 320) { const int cd = tid >> 6, ln = tid & 63; float s = p.in(I_ADAB)[l * 6144 + cg_ * 64 + ln];
#pragma unroll
            for (int w = 0; w < 8; ++w) s += part[(w * 5 + cd) * 64 + ln];
            MOD[((size_t)l * 5 + cd) * 6144 + cg_ * 64 + ln] = s; }
        __syncthreads();
    }
}

__device__ __forceinline__ void p0_hyfilter(const KP& p, const int tid, LAS float* lds_f, int c, int G) {
    LAS float* h1 = lds_f;
    LAS float* h2 = lds_f + 64 * 65;
    const float* w1 = p.in(I_HYFW1); const float* b1 = p.in(I_HYFB1); const float* fq = p.in(I_HYFREQ); const float* w2 = p.in(I_HYFW2); const float* b2 = p.in(I_HYFB2); const float* w3 = p.in(I_HYFW3);
    for (int it = c; it < 144; it += G) {
        const int tc = it >> 2, cgp = it & 3; int L, t0; if (tc < 4) { L = 256; t0 = tc * 64; } else { L = 2048; t0 = (tc - 4) * 64; }
        float* KF = (float*)(p.ws() + (L == 256 ? WS_KF256 : WS_KF2048));
        {
            const int tl = tid >> 3, u0 = (tid & 7) * 8, t = t0 + tl; float a[8];
#pragma unroll
            for (int e = 0; e < 8; ++e) a[e] = b1[u0 + e];
            const float tf = (float)t / (float)(L - 1), ang = 6.283185307179586f * (float)t / (float)L;
#pragma unroll
            for (int e = 0; e < 8; ++e) a[e] += tf * w1[u0 + e];
            for (int j = 0; j < 16; ++j) { const float band = 1e-4f + (float)j * ((15.f - 1e-4f) / 15.f); const float x = band * ang; const float cs = __cosf(x), sn = -__sinf(x);
#pragma unroll
                for (int e = 0; e < 8; ++e) a[e] += cs * w1[(1 + j) * 64 + u0 + e] + sn * w1[(17 + j) * 64 + u0 + e]; }
#pragma unroll
            for (int e = 0; e < 8; ++e) h1[tl * 65 + u0 + e] = __sinf(fq[u0 + e] * a[e]);
        }
        __syncthreads();
        {
            const int tl = tid >> 3, u0 = (tid & 7) * 8; float a[8];
#pragma unroll
            for (int e = 0; e < 8; ++e) a[e] = b2[u0 + e];
            for (int j = 0; j < 64; ++j) { const float hv = h1[tl * 65 + j];
#pragma unroll
                for (int e = 0; e < 8; ++e) a[e] += hv * w2[j * 64 + u0 + e]; }
#pragma unroll
            for (int e = 0; e < 8; ++e) h2[tl * 64 + u0 + e] = __sinf(fq[64 + u0 + e] * a[e]);
        }
        __syncthreads();
        {
            const int cc = cgp * 512 + tid, d = cc & 1023; const bool bwd = cc >= 1024;
            float wc[64];
#pragma unroll
            for (int j = 0; j < 64; ++j) wc[j] = w3[j * 2048 + cc];
            const float da = -15.350567286626973f, db = -3.0701134573253945f; const float adel = fabsf(da + (float)d * ((db - da) / 1023.f));
            for (int tl = 0; tl < 64; ++tl) {
                const int t = t0 + tl; float acc = 0.f;
#pragma unroll
                for (int j = 0; j < 64; j += 4) { const f32x4 hv = *(const LAS f32x4*)(h2 + tl * 64 + j); acc += hv[0] * wc[j] + hv[1] * wc[j + 1] + hv[2] * wc[j + 2] + hv[3] * wc[j + 3]; }
                const float win = __expf(-((float)t / (float)(L - 1)) * adel); float val = acc * win;
                if (t == 0) { if (!bwd) { float acc2 = 0.f; for (int j = 0; j < 64; ++j) acc2 += h2[j] * w3[j * 2048 + cc + 1024]; KF[(size_t)d * 2 * L] = val + acc2; KF[(size_t)d * 2 * L + L] = 0.f; } }
                else KF[(size_t)d * 2 * L + (bwd ? 2 * L - t : t)] = val;
            }
        }
        __syncthreads();
    }
}

struct RowCfg {
    const float* xs_p; const float* xs_s;
    float* xdst;
    const bf16_t* y;
    const float* gate; const float* ng_post;
    const float* ng_pre; const float* sc; const float* sh;
    bf16_t* h;
    const float* mix; bf16_t* xm;
};
__device__ __forceinline__ void compute_row(const RowCfg& cf, int r, int lane, bool store, f32x4 (&hv)[4]) {
    const float* xr = (r < 4096) ? cf.xs_p + (size_t)r * 1024 : cf.xs_s + (size_t)(r - 4096) * 1024;
    const int cd = cond_of(r); f32x4 x[4];
#pragma unroll
    for (int j = 0; j < 4; ++j) x[j] = *(const f32x4*)(xr + 4 * lane + 256 * j);
    if (cf.y) {
        f32x4 yv[4]; float ss = 0.f;
#pragma unroll
        for (int j = 0; j < 4; ++j) { const u32x2 w = *(const u32x2*)(cf.y + (size_t)r * 1024 + 4 * lane + 256 * j); yv[j] = (f32x4){bflo(w.x), bfhi(w.x), bflo(w.y), bfhi(w.y)};
            ss += (yv[j][0] * yv[j][0] + yv[j][1] * yv[j][1]) + (yv[j][2] * yv[j][2] + yv[j][3] * yv[j][3]); }
        const float rstd = rsqrtf(wave_sum(ss) * (1.f / 1024.f) + 1e-6f);
#pragma unroll
        for (int j = 0; j < 4; ++j) { const f32x4 gt = *(const f32x4*)(cf.gate + cd * 6144 + 4 * lane + 256 * j), ng = *(const f32x4*)(cf.ng_post + 4 * lane + 256 * j);
            x[j] += gt * (yv[j] * rstd * ng); }
        if (store && cf.xdst) {
#pragma unroll
            for (int j = 0; j < 4; ++j) *(f32x4*)(cf.xdst + (size_t)r * 1024 + 4 * lane + 256 * j) = x[j];
        }
    }
    if (cf.ng_pre) {
        float ss = 0.f;
#pragma unroll
        for (int j = 0; j < 4; ++j) ss += (x[j][0] * x[j][0] + x[j][1] * x[j][1]) + (x[j][2] * x[j][2] + x[j][3] * x[j][3]);
        const float rstd = rsqrtf(wave_sum(ss) * (1.f / 1024.f) + 1e-6f);
#pragma unroll
        for (int j = 0; j < 4; ++j) { const int cc = 4 * lane + 256 * j; const f32x4 ng = *(const f32x4*)(cf.ng_pre + cc), s1 = *(const f32x4*)(cf.sc + cd * 6144 + cc), s0 = *(const f32x4*)(cf.sh + cd * 6144 + cc);
            hv[j] = x[j] * rstd * ng * (1.f + s1) + s0; }
    }
}
template <bool RW>
__device__ __forceinline__ void row_phase(const RowCfg& cf, int gw, int NGW, int lane) {
    if constexpr (!RW) {
        for (int r = gw; r < T_TOK; r += NGW) {
            f32x4 hv[4]; compute_row(cf, r, lane, true, hv);
            if (cf.ng_pre) {
#pragma unroll
                for (int j = 0; j < 4; ++j) { u32x2 w; w.x = cvt_pk_bf16(hv[j][0], hv[j][1]); w.y = cvt_pk_bf16(hv[j][2], hv[j][3]); *(u32x2*)(cf.h + (size_t)r * 1024 + 4 * lane + 256 * j) = w; }
            }
        }
    } else {
        const int slot[6] = {0, 3, 1, 2, 4, 5};
        for (int st = gw; st < T_TOK / 4; st += NGW) {
            const int t0 = st * 4; int s0, s1;
            if (t0 < 4096) { s0 = t0 & ~255; s1 = s0 + 256; } else { s0 = 4096 + ((t0 - 4096) & ~2047); s1 = s0 + 2048; }
            f32x4 hp[4], hc[4], hn[4];
            if (t0 - 1 >= s0) compute_row(cf, t0 - 1, lane, false, hp); else {
#pragma unroll
                for (int j = 0; j < 4; ++j) hp[j] = (f32x4){0.f, 0.f, 0.f, 0.f}; }
            compute_row(cf, t0, lane, true, hc);
#pragma unroll 1
            for (int i = 0; i < 4; ++i) {
                const int t = t0 + i;
                if (t + 1 < s1) compute_row(cf, t + 1, lane, i < 3, hn); else {
#pragma unroll
                    for (int j = 0; j < 4; ++j) hn[j] = (f32x4){0.f, 0.f, 0.f, 0.f}; }
#pragma unroll
                for (int j = 0; j < 4; ++j) { const int cc = 4 * lane + 256 * j; const f32x4 xx = 0.5f * (hp[j] + hn[j]) - hc[j];
#pragma unroll
                    for (int m = 0; m < 6; ++m) { const f32x4 mx = *(const f32x4*)(cf.mix + m * 1024 + cc); const f32x4 v = hc[j] + xx * mx;
                        u32x2 w; w.x = cvt_pk_bf16(v[0], v[1]); w.y = cvt_pk_bf16(v[2], v[3]);
                        *(u32x2*)(cf.xm + (size_t)slot[m] * T_TOK * 1024 + (size_t)t * 1024 + cc) = w; } }
#pragma unroll
                for (int j = 0; j < 4; ++j) { hp[j] = hc[j]; hc[j] = hn[j]; }
            }
        }
    }
}

__device__ __forceinline__ float shortconv(const bf16_t* row, int t, int L, float c0, float c1, float c2, float cb) {
    const float um = t > 0 ? bf2f(row[t - 1]) : 0.f, u0 = bf2f(row[t]), up = t + 1 < L ? bf2f(row[t + 1]) : 0.f;
    return c0 * um + c1 * u0 + c2 * up + cb;
}
__device__ __forceinline__ void conv8(const LAS float* kf, int mask, const LAS f32x2* z2, int L, int t0, f32x2 (&acc)[8]) {
    f32x4 wl[2], wh[2];
    wh[0] = *(const LAS f32x4*)(kf + ((t0) & mask)); wh[1] = *(const LAS f32x4*)(kf + ((t0 + 4) & mask));
    wl[0] = *(const LAS f32x4*)(kf + ((t0 - 8) & mask)); wl[1] = *(const LAS f32x4*)(kf + ((t0 - 4) & mask));
    for (int s0 = 0; s0 < L; s0 += 8) {
        float w[16];
#pragma unroll
        for (int e = 0; e < 4; ++e) { w[e] = wl[0][e]; w[4 + e] = wl[1][e]; w[8 + e] = wh[0][e]; w[12 + e] = wh[1][e]; }
        f32x2 z[8];
#pragma unroll
        for (int j = 0; j < 8; j += 2) { const f32x4 zz = *(const LAS f32x4*)(z2 + s0 + j); z[j] = (f32x2){zz[0], zz[1]}; z[j + 1] = (f32x2){zz[2], zz[3]}; }
#pragma unroll
        for (int i = 0; i < 8; ++i)
#pragma unroll
            for (int j = 0; j < 8; ++j) acc[i] += w[i - j + 8] * z[j];
        wh[0] = wl[0]; wh[1] = wl[1];
        wl[0] = *(const LAS f32x4*)(kf + ((t0 - s0 - 16) & mask)); wl[1] = *(const LAS f32x4*)(kf + ((t0 - s0 - 12) & mask));
    }
}
__device__ __forceinline__ void hyena_conv_phase(const KP& p, const int tid, LAS unsigned char* lds, int c, int G) {
    const bf16_t* UT = (const bf16_t*)(p.ws() + WS_UT); bf16_t* YO = (bf16_t*)(p.ws() + WS_YO);
    const float* cw = p.in(I_HYCW); const float* cb = p.in(I_HYCB); const float* dsk = p.in(I_HYD);
    {
        LAS float* kfs = (LAS float*)lds; LAS f32x2* z2 = (LAS f32x2*)(lds + 16384);
        const float* KF = (const float*)(p.ws() + WS_KF2048);
        for (int d = c; d < 1024; d += G) {
            for (int i = tid; i < 1024; i += NTHR) *(LAS f32x4*)(kfs + 4 * i) = *(const f32x4*)(KF + (size_t)d * 4096 + 4 * i);
            const float a0 = cw[1024 + d], a1 = cw[3072 + 1024 + d], a2 = cw[6144 + 1024 + d], ab = cb[1024 + d];
            const float v0 = cw[2048 + d], v1 = cw[3072 + 2048 + d], v2 = cw[6144 + 2048 + d], vb = cb[2048 + d];
            for (int idx = tid; idx < 8192; idx += NTHR) { const int b = idx >> 11, t = idx & 2047; const bf16_t* base = UT + (size_t)(4096 + b * 2048) * 3072;
                const float x1c = shortconv(base + (size_t)(1024 + d) * 2048, t, 2048, a0, a1, a2, ab), vc = shortconv(base + (size_t)(2048 + d) * 2048, t, 2048, v0, v1, v2, vb);
                ((LAS float*)z2)[((b >> 1) * 2048 + t) * 2 + (b & 1)] = vc * x1c; }
            __syncthreads();
            const int g2 = tid >> 8, lt = tid & 255, t0 = lt * 8;
            f32x2 acc[8];
#pragma unroll
            for (int i = 0; i < 8; ++i) acc[i] = (f32x2){0.f, 0.f};
            conv8(kfs, 4095, z2 + g2 * 2048, 2048, t0, acc);
            const float x0 = cw[d], x1 = cw[3072 + d], x2 = cw[6144 + d], xb = cb[d], ds = dsk[d];
#pragma unroll
            for (int i = 0; i < 8; ++i) { const int t = t0 + i; const f32x2 zz = z2[g2 * 2048 + t];
#pragma unroll
                for (int e = 0; e < 2; ++e) { const int b = g2 * 2 + e; const bf16_t* base = UT + (size_t)(4096 + b * 2048) * 3072 + (size_t)d * 2048;
                    const float x0c = shortconv(base, t, 2048, x0, x1, x2, xb); const float y = (acc[i][e] + zz[e] * ds) * x0c;
                    YO[(size_t)(4096 + b * 2048 + t) * 1024 + d] = (bf16_t)(cvt_pk_bf16(y, 0.f) & 0xffffu); } }
            __syncthreads();
        }
    }
    {
        LAS float* kfs = (LAS float*)lds; LAS f32x2* z2 = (LAS f32x2*)(lds + 4096);
        const float* KF = (const float*)(p.ws() + WS_KF256);
        for (int dp = c; dp < 512; dp += G) {
            for (int i = tid; i < 256; i += NTHR) *(LAS f32x4*)(kfs + 4 * i) = *(const f32x4*)(KF + (size_t)(dp * 2) * 512 + 4 * i);
            for (int idx = tid; idx < 8192; idx += NTHR) { const int cs = idx >> 12, b = (idx >> 8) & 15, t = idx & 255, d = dp * 2 + cs; const bf16_t* base = UT + (size_t)(b * 256) * 3072;
                const float x1c = shortconv(base + (size_t)(1024 + d) * 256, t, 256, cw[1024 + d], cw[3072 + 1024 + d], cw[6144 + 1024 + d], cb[1024 + d]);
                const float vc = shortconv(base + (size_t)(2048 + d) * 256, t, 256, cw[2048 + d], cw[3072 + 2048 + d], cw[6144 + 2048 + d], cb[2048 + d]);
                ((LAS float*)z2)[((cs * 8 + (b >> 1)) * 256 + t) * 2 + (b & 1)] = vc * x1c; }
            __syncthreads();
            const int cs = tid >> 8, pr = (tid >> 5) & 7, lt = tid & 31, t0 = lt * 8, d = dp * 2 + cs;
            f32x2 acc[8];
#pragma unroll
            for (int i = 0; i < 8; ++i) acc[i] = (f32x2){0.f, 0.f};
            conv8(kfs + cs * 512, 511, z2 + (cs * 8 + pr) * 256, 256, t0, acc);
            const float x0 = cw[d], x1 = cw[3072 + d], x2 = cw[6144 + d], xb = cb[d], ds = dsk[d];
#pragma unroll
            for (int i = 0; i < 8; ++i) { const int t = t0 + i; const f32x2 zz = z2[(cs * 8 + pr) * 256 + t];
#pragma unroll
                for (int e = 0; e < 2; ++e) { const int b = pr * 2 + e; const bf16_t* base = UT + (size_t)(b * 256) * 3072 + (size_t)d * 256;
                    const float x0c = shortconv(base, t, 256, x0, x1, x2, xb); const float y = (acc[i][e] + zz[e] * ds) * x0c;
                    YO[(size_t)(b * 256 + t) * 1024 + d] = (bf16_t)(cvt_pk_bf16(y, 0.f) & 0xffffu); } }
            __syncthreads();
        }
    }
}

constexpr int TC = 32;
__device__ __forceinline__ void scan_item(const KP& p, const int tid, LAS unsigned char* lds, int start, int L, int b, int h, int dir, bool sample) {
    LAS float* KKN = (LAS float*)lds; LAS float* Qs = KKN + TC * 64; LAS float* Ws = Qs + TC * 64; LAS float* Bs = Ws + TC * 64; LAS float* KDs = Bs + TC * 64; LAS float* Vs = KDs + TC * 64;
    LAS float* OBs = Vs + TC * 64; LAS float* BG = OBs + TC * 64;
    const int v = tid >> 3, kq = tid & 7;
    const bf16_t* RKV = (const bf16_t*)(p.ws() + WS_RKV); const bf16_t* E = (const bf16_t*)(p.ws() + WS_E) + (size_t)dir * T_TOK * 1024; const bf16_t* AA = (const bf16_t*)(p.ws() + WS_AA) + (size_t)dir * T_TOK * 1024;
    bf16_t* O = (bf16_t*)(p.ws() + (dir == 0 ? WS_OF : WS_OB));
    float s[8];
    if (sample) { const float* st = p.in(dir == 0 ? I_SF : I_SB) + (((size_t)b * 16 + h) * 64 + v) * 64 + kq * 8;
#pragma unroll
        for (int e = 0; e < 8; ++e) s[e] = st[e];
    } else {
#pragma unroll
        for (int e = 0; e < 8; ++e) s[e] = 0.f;
    }
    const int ptl = tid >> 4, pk = (tid & 15) * 4, col = h * 64 + pk;
    const f32x4 kkw = *(const f32x4*)(p.in(I_KK) + col), kaw = *(const f32x4*)(p.in(I_KA) + col);
    const int nch = L / TC;
    for (int ch = 0; ch < nch; ++ch) {
        const int tbase = dir == 0 ? ch * TC : L - (ch + 1) * TC;
        {
            const size_t ro = (size_t)(start + tbase + ptl) * 1024 + col;
            const u32x2 rw = *(const u32x2*)(RKV + ro), kw = *(const u32x2*)(RKV + (size_t)T_TOK * 1024 + ro), vw = *(const u32x2*)(RKV + (size_t)2 * T_TOK * 1024 + ro), ew = *(const u32x2*)(E + ro), aw = *(const u32x2*)(AA + ro);
            const f32x4 r4 = {bflo(rw.x), bfhi(rw.x), bflo(rw.y), bfhi(rw.y)}, k4 = {bflo(kw.x), bfhi(kw.x), bflo(kw.y), bfhi(kw.y)}, v4 = {bflo(vw.x), bfhi(vw.x), bflo(vw.y), bfhi(vw.y)};
            const f32x4 e4 = {bflo(ew.x), bfhi(ew.x), bflo(ew.y), bfhi(ew.y)}, a4 = {bflo(aw.x), bfhi(aw.x), bflo(aw.y), bfhi(aw.y)};
            f32x4 kk = k4 * kkw; float n2 = (kk[0] * kk[0] + kk[1] * kk[1]) + (kk[2] * kk[2] + kk[3] * kk[3]);
            n2 = sum16(n2);
            const float inv = 1.f / fmaxf(sqrtf(n2), 1e-12f); kk = kk * inv;
            f32x4 w;
#pragma unroll
            for (int e = 0; e < 4; ++e) w[e] = __expf(-e4[e]);
            const f32x4 kd = k4 * (1.f + (a4 - 1.f) * kaw), bb = kk * a4, q = w * r4;
            float be = (bb[0] * r4[0] + bb[1] * r4[1]) + (bb[2] * r4[2] + bb[3] * r4[3]), ga = (kd[0] * r4[0] + kd[1] * r4[1]) + (kd[2] * r4[2] + kd[3] * r4[3]);
            be = sum16(be);
            ga = sum16(ga);
            const int o = ptl * 64 + pk;
            *(LAS f32x4*)(KKN + o) = -kk; *(LAS f32x4*)(Qs + o) = q; *(LAS f32x4*)(Ws + o) = w; *(LAS f32x4*)(Bs + o) = bb; *(LAS f32x4*)(KDs + o) = kd; *(LAS f32x4*)(Vs + o) = v4;
            if ((tid & 15) == 0) { BG[ptl * 2] = be; BG[ptl * 2 + 1] = ga; }
        }
        __syncthreads();
        for (int st = 0; st < TC; ++st) {
            const int tl = dir == 0 ? st : TC - 1 - st; const int o = tl * 64 + kq * 8;
            const f32x4 k0 = *(const LAS f32x4*)(KKN + o), k1 = *(const LAS f32x4*)(KKN + o + 4), q0 = *(const LAS f32x4*)(Qs + o), q1 = *(const LAS f32x4*)(Qs + o + 4);
            const f32x4 w0 = *(const LAS f32x4*)(Ws + o), w1 = *(const LAS f32x4*)(Ws + o + 4), b0 = *(const LAS f32x4*)(Bs + o), b1 = *(const LAS f32x4*)(Bs + o + 4);
            const f32x4 d0 = *(const LAS f32x4*)(KDs + o), d1 = *(const LAS f32x4*)(KDs + o + 4);
            const float vv = Vs[tl * 64 + v], be = BG[tl * 2], ga = BG[tl * 2 + 1];
            float sa = 0.f, pp = 0.f;
#pragma unroll
            for (int e = 0; e < 4; ++e) { sa += s[e] * k0[e] + s[4 + e] * k1[e]; pp += s[e] * q0[e] + s[4 + e] * q1[e]; }
            sa = sum8(sa); pp = sum8(pp);
#pragma unroll
            for (int e = 0; e < 4; ++e) { s[e] = s[e] * w0[e] + sa * b0[e] + vv * d0[e]; s[4 + e] = s[4 + e] * w1[e] + sa * b1[e] + vv * d1[e]; }
            if (kq == 0) OBs[tl * 64 + v] = pp + sa * be + vv * ga;
        }
        __syncthreads();
        { const f32x4 ov = *(const LAS f32x4*)(OBs + ptl * 64 + pk); u32x2 w; w.x = cvt_pk_bf16(ov[0], ov[1]); w.y = cvt_pk_bf16(ov[2], ov[3]);
          *(u32x2*)(O + (size_t)(start + tbase + ptl) * 1024 + col) = w; }
    }
    if (!sample) { float* so = p.out() + (size_t)T_TOK * 1024 + (size_t)dir * 1048576 + (((size_t)b * 16 + h) * 64 + v) * 64 + kq * 8;
#pragma unroll
        for (int e = 0; e < 8; ++e) so[e] = s[e]; }
    __syncthreads();
}
__device__ __forceinline__ void scan_phase(const KP& p, const int tid, LAS unsigned char* lds, int c, int G) {
    if (G == 256) {
        if (c < 128) { const int b = c >> 5, h = (c >> 1) & 15, dir = c & 1; scan_item(p, tid, lds, 4096 + b * 2048, 2048, b, h, dir, true); }
        else { for (int i = 0; i < 4; ++i) { const int q = (c - 128) * 4 + i; const int b = q >> 5, h = (q >> 1) & 15, dir = q & 1; scan_item(p, tid, lds, b * 256, 256, b, h, dir, false); } }
    } else {
        for (int it = c; it < 640; it += G) {
            if (it < 128) { const int b = it >> 5, h = (it >> 1) & 15, dir = it & 1; scan_item(p, tid, lds, 4096 + b * 2048, 2048, b, h, dir, true); }
            else { const int q = it - 128; const int b = q >> 5, h = (q >> 1) & 15, dir = q & 1; scan_item(p, tid, lds, b * 256, 256, b, h, dir, false); }
        }
    }
}
__device__ __forceinline__ void rwkv_post_phase(const KP& p, int gw, int NGW, int lane) {
    const bf16_t* RKV = (const bf16_t*)(p.ws() + WS_RKV); const bf16_t* AA = (const bf16_t*)(p.ws() + WS_AA); const bf16_t* Gb = (const bf16_t*)(p.ws() + WS_G);
    bf16_t* OF = (bf16_t*)(p.ws() + WS_OF); const bf16_t* OB = (const bf16_t*)(p.ws() + WS_OB);
    const size_t TS = (size_t)T_TOK * 1024;
    for (int pr = gw; pr < T_TOK * 16; pr += NGW) {
        const int row = pr >> 4, h = pr & 15, cc = h * 64 + lane; const size_t o = (size_t)row * 1024 + cc;
        const float ov = bf2f(OF[o]) + bf2f(OB[o]); const float mu = wave_sum(ov) * (1.f / 64.f), dd = ov - mu; const float var = wave_sum(dd * dd) * (1.f / 64.f);
        float on = dd * rsqrtf(var + 64e-5f) * p.in(I_LNW)[cc] + p.in(I_LNB)[cc];
        const float r = bf2f(RKV[o]), k = bf2f(RKV[TS + o]), vv = bf2f(RKV[2 * TS + o]), af = bf2f(AA[o]), ab = bf2f(AA[TS + o]), ka = p.in(I_KA)[cc];
        const float kd2 = k * (2.f + (af + ab - 2.f) * ka);
        const float rho = wave_sum(r * kd2 * p.in(I_RK)[cc]);
        on += rho * vv;
        OF[o] = (bf16_t)(cvt_pk_bf16(on * bf2f(Gb[o]), 0.f) & 0xffffu);
    }
}

#define PE(code, l, nosync) (unsigned char)((code) | ((l) << 5) | ((nosync) << 7))
__device__ const unsigned char PROG[34] = {
    PE(PH_PREP, 0, 0), PE(PH_R0, 0, 0),
    PE(PH_FG1, 0, 0), PE(PH_FG2S, 0, 1), PE(PH_FG2P, 0, 0), PE(PH_FG3, 0, 0), PE(PH_RMID, 0, 0), PE(PH_NG1, 0, 0), PE(PH_NG2, 0, 0), PE(PH_REND, 0, 0),
    PE(PH_HG1, 1, 0), PE(PH_HC, 1, 0), PE(PH_HG2, 1, 0), PE(PH_RMID, 1, 0), PE(PH_NG1, 1, 0), PE(PH_NG2, 1, 0), PE(PH_REND, 1, 0),
    PE(PH_RG1, 2, 0), PE(PH_RG2, 2, 0), PE(PH_RS, 2, 0), PE(PH_RP, 2, 0), PE(PH_RG3, 2, 0), PE(PH_RMID, 2, 0), PE(PH_NG1, 2, 0), PE(PH_NG2, 2, 0), PE(PH_REND, 2, 0),
    PE(PH_FG1, 3, 0), PE(PH_FG2S, 3, 1), PE(PH_FG2P, 3, 0), PE(PH_FG3, 3, 0), PE(PH_RMID, 3, 0), PE(PH_NG1, 3, 0), PE(PH_NG2, 3, 0), PE(PH_REND, 3, 1) };

__global__ void __launch_bounds__(NTHR) mega_fwd(Params pp) {
    extern __shared__ __attribute__((aligned(16))) unsigned char lds_raw[];
    const EpiGen E;
#pragma unroll 1
    for (int ph = 0; ph < 34; ++ph) {
        unsigned long long kv = (unsigned long long)__builtin_amdgcn_kernarg_segment_ptr(); asm volatile("" : "+s"(kv));
        int tid = threadIdx.x; asm volatile("" : "+v"(tid));
        int G = gridDim.x, bx = blockIdx.x; asm volatile("" : "+s"(G), "+s"(bx));
        unsigned ldsv = (unsigned)(size_t)(LAS unsigned char*)lds_raw; asm volatile("" : "+s"(ldsv));
        LAS unsigned char* lds = (LAS unsigned char*)(size_t)ldsv;
        const int lane = tid & 63, wave = __builtin_amdgcn_readfirstlane(tid >> 6);
        const int c = (G % 8 == 0) ? (bx % 8) * (G / 8) + bx / 8 : bx;
        const int gw = c * NWAVES + wave, NGW = G * NWAVES, gtid = c * NTHR + tid, NT = G * NTHR;
        LAS float* scr = (LAS float*)(lds + wave * 8448);
        const KP p{(kin_t)kv}; unsigned char* ws = p.ws(); const float* MOD = (const float*)(ws + WS_MOD);
        const unsigned pe = PROG[ph]; const int code = pe & 31, l = (pe >> 5) & 3; const bool nosync = (pe >> 7) != 0;
        if (code >= 8) {
            int lda = 1024, ldb = 1024, nt = 16;
            if (code == PH_FG1) { lda = 256; nt = 4; } else if (code == PH_FG2S) { lda = 4096; ldb = 4096; nt = 64; } else if (code == PH_FG2P) { lda = 512; ldb = 512; nt = 8; }
            else if (code == PH_RG2) { lda = 384; ldb = 256; nt = 4; } else if (code == PH_NG2) { lda = FF; ldb = FF; nt = 44; }
            SchedAny S{code, l, G, c, ws};
            gemm_phase<true>(tid, lds, lda, ldb, nt, S, E);
        } else if (code == PH_PREP) {
            p0_transposes(p, scr, gw, NGW, lane);
            p0_tables(p, gtid, NT);
            __syncthreads();
            p0_mod(p, tid, (LAS float*)lds, c, G);
            p0_hyfilter(p, tid, (LAS float*)lds, c, G);
        } else if (code == PH_HC) {
            hyena_conv_phase(p, tid, lds, c, G);
        } else if (code == PH_RS) {
            scan_phase(p, tid, lds, c, G);
        } else if (code == PH_RP) {
            rwkv_post_phase(p, gw, NGW, lane);
        } else {
            const float* modl = MOD + (size_t)l * 5 * 6144; const float* ngl = p.in(I_NG) + (size_t)l * 4 * 1024;
            RowCfg cf; cf.h = (bf16_t*)(ws + WS_H); cf.mix = p.in(I_MIX); cf.xm = (bf16_t*)(ws + WS_XM); cf.y = (const bf16_t*)(ws + WS_Y);
            cf.xs_p = (const float*)(ws + WS_X); cf.xs_s = (const float*)(ws + WS_X) + (size_t)4096 * 1024; cf.xdst = (float*)(ws + WS_X);
            bool rw = false;
            if (code == PH_R0) { cf.xs_p = p.in(I_XP); cf.xs_s = p.in(I_XS); cf.xdst = nullptr; cf.y = nullptr; cf.gate = nullptr; cf.ng_post = nullptr; cf.ng_pre = ngl; cf.sc = modl + 1024; cf.sh = modl; }
            else if (code == PH_RMID) {
                convert_ffn(p, l, scr, gw, NGW, lane);
                if (l == 0) { cf.xs_p = p.in(I_XP); cf.xs_s = p.in(I_XS); }
                if (l == 2) { cf.xs_p = p.out(); cf.xs_s = p.out() + (size_t)4096 * 1024; }
                cf.gate = modl + 2048; cf.ng_post = ngl + 1024; cf.ng_pre = ngl + 2048; cf.sc = modl + 4096; cf.sh = modl + 3072;
            } else {
                cf.gate = modl + 5120; cf.ng_post = ngl + 3072;
                if (l == 3) { cf.xdst = p.out(); cf.ng_pre = nullptr; cf.sc = nullptr; cf.sh = nullptr; }
                else { cf.ng_pre = ngl + 4096; cf.sc = modl + 5 * 6144 + 1024; cf.sh = modl + 5 * 6144; rw = ((l + 1) % 3 == 2); if (rw) cf.xdst = p.out(); }
            }
            if (rw) row_phase<true>(cf, gw, NGW, lane); else row_phase<false>(cf, gw, NGW, lane);
        }
        if (!nosync) cg::this_grid().sync();
    }
}

extern "C" void kernel_launch(void* const* d_in, const int* in_sizes, int n_in, void* d_out, int out_size, void* d_ws, size_t ws_size, hipStream_t stream) {
    static int grid = 0;
    if (grid == 0) {
        if (n_in != 45 || ws_size < WS_END) { fprintf(stderr, "kernel_launch: need 45 inputs and %zu bytes of workspace; got %d, %zu\n", (size_t)WS_END, n_in, ws_size); grid = -1; return; }
        int dev = 0, cus = 0, per_cu = 0;
        hipGetDevice(&dev); hipDeviceGetAttribute(&cus, hipDeviceAttributeMultiprocessorCount, dev);
        if (hipFuncSetAttribute((const void*)mega_fwd, hipFuncAttributeMaxDynamicSharedMemorySize, LDS_BYTES) != hipSuccess) { fprintf(stderr, "kernel_launch: hipFuncSetAttribute failed\n"); grid = -1; return; }
        if (hipOccupancyMaxActiveBlocksPerMultiprocessor(&per_cu, (const void*)mega_fwd, NTHR, LDS_BYTES) != hipSuccess || per_cu < 1) { fprintf(stderr, "kernel_launch: occupancy query failed (%d)\n", per_cu); (void)hipGetLastError(); per_cu = 1; }
        grid = cus * 1;
    }
    if (grid < 0) return;
    Params a{};
    for (int i = 0; i < 45; ++i) a.in[i] = (const float*)d_in[i];
    a.out = (float*)d_out; a.ws = (unsigned char*)d_ws;
    void* args[] = {&a};
    hipError_t e = hipLaunchCooperativeKernel((const void*)mega_fwd, dim3(grid), dim3(NTHR), args, LDS_BYTES, stream);
    if (e != hipSuccess) fprintf(stderr, "cooperative launch failed: %s (grid %d)\n", hipGetErrorString(e), grid);
}
```

```cpp
#include <hip/hip_runtime.h>
#include <hip/hip_cooperative_groups.h>
#include <cstdio>
#include <cstdint>
namespace cg = cooperative_groups;

#define LAS __attribute__((address_space(3)))
typedef unsigned short bf16_t;
typedef short bf16x8 __attribute__((ext_vector_type(8)));
typedef float f32x4 __attribute__((ext_vector_type(4)));
typedef float f32x2 __attribute__((ext_vector_type(2)));
typedef unsigned u32x4 __attribute__((ext_vector_type(4)));
typedef unsigned u32x2 __attribute__((ext_vector_type(2)));

constexpr int T_TOK = 12288, DM = 1024, FF = 2816;
constexpr int NTHR = 512, NWAVES = 8;
constexpr int LDS_BYTES = 163840;

constexpr size_t SZ_TD2 = (size_t)T_TOK * DM * 2;
constexpr size_t WS_CTL = 0, CTL_BYTES = 32768;
constexpr size_t WS_XBUF = 32768;
constexpr size_t WS_MOD = WS_XBUF + 2 * (size_t)T_TOK * 16;
constexpr size_t WS_BIAS = WS_MOD + 491520;
constexpr size_t WS_W13T = WS_BIAS + 40960;
constexpr size_t WS_W2T = WS_W13T + (size_t)5632 * 1024 * 2;
constexpr size_t WS_FNWT = WS_W2T + (size_t)1024 * 2816 * 2;
constexpr size_t WS_HYWINT = WS_FNWT + 2 * 2097152;
constexpr size_t WS_HYWOUTT = WS_HYWINT + 6291456;
constexpr size_t WS_RWT = WS_HYWOUTT + 2097152;
constexpr size_t WS_LORA1T = WS_RWT + 6291456;
constexpr size_t WS_WOT = WS_LORA1T + 1572864;
constexpr size_t WS_LORA2T = WS_WOT + 2097152;
constexpr size_t WS_CS256 = WS_LORA2T + 2621440;
constexpr size_t WS_SEQ256 = WS_CS256 + 262144;
constexpr size_t WS_SEQ2048 = WS_SEQ256 + 262144;
constexpr size_t WS_X = WS_SEQ2048 + 16777216;
constexpr size_t WS_H = WS_X + (size_t)T_TOK * DM * 4;
constexpr size_t WS_L1 = WS_H + SZ_TD2;
constexpr size_t WS_Y = WS_L1 + (size_t)T_TOK * 384 * 2;
constexpr size_t WS_S1 = WS_Y + SZ_TD2;
constexpr size_t WS_S2 = WS_S1 + 6 * SZ_TD2;
constexpr size_t WS_END = WS_S2 + 3 * SZ_TD2;
constexpr size_t WS_TB = WS_S1;
constexpr size_t WS_HCST = WS_S1;
constexpr size_t WS_FOUT = WS_S1 + 2 * SZ_TD2;
constexpr size_t WS_UT = WS_S1;
constexpr size_t WS_YO = WS_S1 + 3 * SZ_TD2;
constexpr size_t WS_YOT = WS_S1 + 4 * SZ_TD2;
constexpr size_t WS_KF2048 = WS_S2;
constexpr size_t WS_KF256 = WS_S2 + 16777216;
constexpr size_t WS_XM = WS_S1;
constexpr size_t WS_RKV = WS_S2;
constexpr size_t WS_G = WS_S1;
constexpr size_t WS_E = WS_S1 + SZ_TD2;
constexpr size_t WS_AA = WS_S1 + 3 * SZ_TD2;
constexpr size_t WS_OF = WS_S1 + 5 * SZ_TD2;
constexpr size_t WS_OB = WS_H;

struct Params { const float* in[45]; float* out; unsigned char* ws; };
typedef const float* const __attribute__((address_space(4)))* kin_t;
struct KP { kin_t k;
    __device__ __forceinline__ const float* in(int i) const { return k[i]; }
    __device__ __forceinline__ float* out() const { return (float*)k[45]; }
    __device__ __forceinline__ unsigned char* ws() const { return (unsigned char*)k[46]; } };

enum { I_XP = 0, I_XS, I_SF, I_SB, I_C, I_CCTX, I_ADAW, I_ADAB, I_NG, I_W1, I_W3, I_W2, I_FNW, I_FNB, I_HYWIN, I_HYBIN, I_HYCW, I_HYCB,
       I_HYFW1, I_HYFB1, I_HYFREQ, I_HYFW2, I_HYFB2, I_HYFW3, I_HYD, I_HYWOUT, I_HYBOUT, I_MIX, I_WR, I_WK, I_WV, I_WO, I_W0, I_RW1, I_RW2,
       I_A0, I_A1, I_A2, I_G1, I_G2, I_KK, I_KA, I_RK, I_LNW, I_LNB };

__device__ __forceinline__ unsigned cvt_pk_bf16(float lo, float hi) { unsigned r; asm volatile("v_cvt_pk_bf16_f32 %0, %1, %2" : "=v"(r) : "v"(lo), "v"(hi)); return r; }
__device__ __forceinline__ float bf2f(unsigned short b) { return __builtin_bit_cast(float, (unsigned)b << 16); }
__device__ __forceinline__ float bflo(unsigned w) { return __builtin_bit_cast(float, w << 16); }
__device__ __forceinline__ float bfhi(unsigned w) { return __builtin_bit_cast(float, w & 0xffff0000u); }
template <int CTRL> __device__ __forceinline__ float dpp_f(float v) { return __builtin_bit_cast(float, __builtin_amdgcn_mov_dpp(__builtin_bit_cast(int, v), CTRL, 0xf, 0xf, true)); }
__device__ __forceinline__ float sum4(float v) { v += dpp_f<0xB1>(v); v += dpp_f<0x4E>(v); return v; }
__device__ __forceinline__ float sum8(float v) { v = sum4(v); v += dpp_f<0x141>(v); return v; }
__device__ __forceinline__ float sum16(float v) { v = sum8(v); v += dpp_f<0x140>(v); return v; }
__device__ __forceinline__ float wave_sum(float v) {
    v = sum16(v);
    const int iv = __builtin_bit_cast(int, v);
    return (__builtin_bit_cast(float, __builtin_amdgcn_readlane(iv, 0)) + __builtin_bit_cast(float, __builtin_amdgcn_readlane(iv, 16)))
         + (__builtin_bit_cast(float, __builtin_amdgcn_readlane(iv, 32)) + __builtin_bit_cast(float, __builtin_amdgcn_readlane(iv, 48)));
}
__device__ __forceinline__ int cond_of(int r) { return r < 4096 ? 0 : 1 + ((r - 4096) >> 11); }
__device__ __forceinline__ void tile_seq(int tt, int& start, int& L, int& l0) {
    if (tt < 16) { start = tt * 256; L = 256; l0 = 0; } else { const int j = (tt - 16) >> 3; start = 4096 + j * 2048; L = 2048; l0 = ((tt - 16) & 7) * 256; }
}
__device__ __forceinline__ float sigmoidf_(float x) { return __builtin_amdgcn_rcpf(1.f + __expf(-x)); }

constexpr int BK = 64, HALF = 128, HTB = HALF * BK * 2;
__device__ __forceinline__ int lds_byte(int r, int c) { const int st = (r >> 4) * 2 + (c >> 5), rr = r & 15, cc = c & 31, ob = rr * 64 + cc * 2; return st * 1024 + (ob ^ (((ob >> 9) & 1) << 5)); }
__device__ __forceinline__ void stage_rc(int b, int& R, int& C) { const int st = b / 1024, sb = b % 1024, swz = sb ^ (((sb >> 9) & 1) << 5); R = (st >> 1) * 16 + swz / 64; C = (st & 1) * 32 + (swz % 64) / 2; }

struct Unit { const char* A; const char* B; char* O; const float* bcol; const float* brow; int ldc; int mode; };
enum { EM_PLAIN = 0, EM_SWIGLU = 1, EM_TANH128 = 2, EM_SIG128 = 3, EM_ID128 = 4, EM_DECAY = 5, EM_SIGB = 6, EM_FUSED = 7 };
enum { PH_FG3_ = 11, PH_HG2_ = 13, PH_NG2_ = 18 };

struct EpiGen {
    int code, l, c; KP p;
    __device__ __forceinline__ void exchange(int ex, int pm, int pn, unsigned want, LAS float* P, LAS float* S, int wid, int lane) const {
        const int tid = wid * 64 + lane; unsigned char* ws = p.ws();
        float* xbuf = (float*)(ws + WS_XBUF) + (size_t)ex * T_TOK * 4; unsigned* cnt = (unsigned*)(ws + WS_CTL + 16384) + (ex * 48 + pm) * 16;
        asm volatile("s_waitcnt lgkmcnt(0)" ::: "memory"); __builtin_amdgcn_s_barrier(); asm volatile("" ::: "memory");
        if (tid < 256) { const LAS f32x4* pr = (const LAS f32x4*)(P + tid * 16); const f32x4 a = pr[0], b = pr[1], cc = pr[2], d = pr[3];
            const float tot = ((a[0] + a[1]) + (a[2] + a[3])) + ((b[0] + b[1]) + (b[2] + b[3])) + ((cc[0] + cc[1]) + (cc[2] + cc[3])) + ((d[0] + d[1]) + (d[2] + d[3]));
            __hip_atomic_store(xbuf + (size_t)(pm * 256 + tid) * 4 + pn, tot, __ATOMIC_RELAXED, __HIP_MEMORY_SCOPE_AGENT); }
        asm volatile("s_waitcnt vmcnt(0)" ::: "memory");
        if (wid < 4 && lane == 0) __hip_atomic_fetch_add(cnt, 1u, __ATOMIC_RELAXED, __HIP_MEMORY_SCOPE_AGENT);
        if (wid == 0) { unsigned spins = 0;
            while ((unsigned)__builtin_amdgcn_readfirstlane(__hip_atomic_load(cnt, __ATOMIC_RELAXED, __HIP_MEMORY_SCOPE_AGENT)) < want) { __builtin_amdgcn_s_sleep(1); if (++spins > (1u << 15)) break; }
            __builtin_amdgcn_fence(__ATOMIC_ACQUIRE, "agent"); }
        asm volatile("s_waitcnt vmcnt(0) lgkmcnt(0)" ::: "memory"); __builtin_amdgcn_s_barrier(); asm volatile("" ::: "memory");
        if (tid < 256) { const float* sl = xbuf + (size_t)(pm * 256 + tid) * 4; float t = 0.f;
#pragma unroll
            for (int k = 0; k < 4; ++k) t += __hip_atomic_load(sl + k, __ATOMIC_RELAXED, __HIP_MEMORY_SCOPE_AGENT);
            S[tid] = rsqrtf(t * (1.f / 1024.f) + 1e-6f); }
        asm volatile("s_waitcnt lgkmcnt(0)" ::: "memory"); __builtin_amdgcn_s_barrier(); asm volatile("" ::: "memory");
    }
    __device__ __forceinline__ void fused(f32x4 (&acc)[2][2][4][2], int wr, int wc, int fr, int fq, LAS unsigned char* lds, int wid, int lane) const {
        unsigned char* ws = p.ws();
        const int pm = c >> 2, pn = c & 3, cond = pm < 16 ? 0 : 1 + ((pm - 16) >> 3);
        const bool mid = code != PH_NG2_, has_next = mid || l < 3;
        const float* modl = (const float*)(ws + WS_MOD) + ((size_t)l * 5 + cond) * 6144; const float* ngl = p.in(I_NG) + l * 4096;
        const float* gate = modl + (mid ? 2048 : 5120); const float* ngp = ngl + (mid ? 1024 : 3072);
        const float* bias = code == PH_FG3_ ? p.in(I_FNB) + (l / 3) * 1024 : (code == PH_HG2_ ? p.in(I_HYBOUT) : nullptr);
        const float* xsrc = (mid && l == 0) ? (pm < 16 ? p.in(I_XP) + (size_t)pm * 262144 : p.in(I_XS) + (size_t)(pm - 16) * 262144) : (const float*)(ws + WS_X) + (size_t)pm * 262144;
        float* xdst = (!mid && l == 3) ? p.out() + (size_t)pm * 262144 : (float*)(ws + WS_X) + (size_t)pm * 262144;
        bf16_t* hdst = (bf16_t*)(ws + WS_H) + (size_t)pm * 262144;
        LAS float* P = (LAS float*)(lds + 131072); LAS float* S = P + 4096;
        const int col0 = pn * 256 + wc * 32 + 4 * fq; const unsigned want = 16u * (unsigned)(2 * l + (mid ? 1 : 2));
        { float sq[2][4];
#pragma unroll
          for (int ai = 0; ai < 2; ++ai)
#pragma unroll
            for (int m = 0; m < 4; ++m) sq[ai][m] = 0.f;
#pragma unroll
          for (int bj = 0; bj < 2; ++bj)
#pragma unroll
            for (int n = 0; n < 2; ++n) { f32x4 bvec = {0.f, 0.f, 0.f, 0.f}; if (bias) bvec = *(const f32x4*)(bias + col0 + bj * 128 + n * 16);
#pragma unroll
                for (int ai = 0; ai < 2; ++ai)
#pragma unroll
                    for (int m = 0; m < 4; ++m) { const f32x4 v = acc[ai][bj][m][n] + bvec; acc[ai][bj][m][n] = v; sq[ai][m] += (v[0] * v[0] + v[1] * v[1]) + (v[2] * v[2] + v[3] * v[3]); } }
#pragma unroll
          for (int ai = 0; ai < 2; ++ai)
#pragma unroll
            for (int m = 0; m < 4; ++m) P[(ai * 128 + wr * 64 + m * 16 + fr) * 16 + wc * 4 + fq] = sq[ai][m]; }
        exchange(0, pm, pn, want, P, S, wid, lane);
        { f32x4 g4[2][2];
#pragma unroll
          for (int bj = 0; bj < 2; ++bj)
#pragma unroll
            for (int n = 0; n < 2; ++n) g4[bj][n] = *(const f32x4*)(gate + col0 + bj * 128 + n * 16) * *(const f32x4*)(ngp + col0 + bj * 128 + n * 16);
#pragma unroll
          for (int ai = 0; ai < 2; ++ai)
#pragma unroll
            for (int m = 0; m < 4; ++m) { const int row = ai * 128 + wr * 64 + m * 16 + fr; const float rs = S[row]; float sq = 0.f;
                f32x4 xv[2][2];
#pragma unroll
                for (int bj = 0; bj < 2; ++bj)
#pragma unroll
                    for (int n = 0; n < 2; ++n) xv[bj][n] = *(const f32x4*)(xsrc + (size_t)row * 1024 + col0 + bj * 128 + n * 16);
#pragma unroll
                for (int bj = 0; bj < 2; ++bj)
#pragma unroll
                    for (int n = 0; n < 2; ++n) { const size_t off = (size_t)row * 1024 + col0 + bj * 128 + n * 16; const f32x4 x = xv[bj][n];
                        const f32x4 xn = x + g4[bj][n] * (acc[ai][bj][m][n] * rs); acc[ai][bj][m][n] = xn; *(f32x4*)(xdst + off) = xn; sq += (xn[0] * xn[0] + xn[1] * xn[1]) + (xn[2] * xn[2] + xn[3] * xn[3]); }
                asm volatile("" : "+v"(acc[ai][0][m][0]), "+v"(acc[ai][0][m][1]), "+v"(acc[ai][1][m][0]), "+v"(acc[ai][1][m][1]));
                if (has_next) P[row * 16 + wc * 4 + fq] = sq;
                if (m & 1) asm volatile("" ::: "memory"); } }
        if (!has_next) return;
        exchange(1, pm, pn, want, P, S, wid, lane);
        { const float* ngn = mid ? ngl + 2048 : ngl + 4096; const float* scn = mid ? modl + 4096 : modl + 5 * 6144 + 1024; const float* shn = mid ? modl + 3072 : modl + 5 * 6144;
          f32x4 a4[2][2], s4[2][2];
#pragma unroll
          for (int bj = 0; bj < 2; ++bj)
#pragma unroll
            for (int n = 0; n < 2; ++n) { const int cc = col0 + bj * 128 + n * 16; a4[bj][n] = *(const f32x4*)(ngn + cc) * (1.f + *(const f32x4*)(scn + cc)); s4[bj][n] = *(const f32x4*)(shn + cc); }
#pragma unroll
          for (int ai = 0; ai < 2; ++ai)
#pragma unroll
            for (int m = 0; m < 4; ++m) { const int row = ai * 128 + wr * 64 + m * 16 + fr; const float rs = S[row];
#pragma unroll
                for (int bj = 0; bj < 2; ++bj)
#pragma unroll
                    for (int n = 0; n < 2; ++n) { const f32x4 hv = acc[ai][bj][m][n] * rs * a4[bj][n] + s4[bj][n]; u32x2 w; w.x = cvt_pk_bf16(hv[0], hv[1]); w.y = cvt_pk_bf16(hv[2], hv[3]);
                        *(u32x2*)(hdst + (size_t)row * 1024 + col0 + bj * 128 + n * 16) = w; } } }
    }
    __device__ __forceinline__ void operator()(f32x4 (&acc)[2][2][4][2], const Unit& u, int wr, int wc, int fr, int fq, LAS unsigned char* lds, int wid, int lane) const {
        if (u.mode == EM_FUSED) { fused(acc, wr, wc, fr, fq, lds, wid, lane); return; }
        bf16_t* O = (bf16_t*)u.O; const int ldc = u.ldc, mode = u.mode;
        if (mode == EM_SWIGLU) {
#pragma unroll
            for (int ai = 0; ai < 2; ++ai)
#pragma unroll
                for (int m = 0; m < 4; ++m) {
                    const int row = ai * HALF + wr * 64 + m * 16 + fr;
#pragma unroll
                    for (int bj = 0; bj < 2; ++bj) {
                        const f32x4 a = acc[ai][bj][m][0], b = acc[ai][bj][m][1]; f32x4 o;
#pragma unroll
                        for (int e = 0; e < 4; ++e) o[e] = a[e] * sigmoidf_(a[e]) * b[e];
                        u32x2 w; w.x = cvt_pk_bf16(o[0], o[1]); w.y = cvt_pk_bf16(o[2], o[3]);
                        *(u32x2*)(O + (size_t)row * ldc + bj * 64 + wc * 16 + fq * 4) = w;
                    }
                }
            return;
        }
        const bool half_only = (mode == EM_TANH128 || mode == EM_SIG128 || mode == EM_ID128);
#pragma unroll
        for (int ai = 0; ai < 2; ++ai)
#pragma unroll
            for (int m = 0; m < 4; ++m) {
                const int row = ai * HALF + wr * 64 + m * 16 + fr;
                const float br = u.brow ? u.brow[row] : 0.f;
#pragma unroll
                for (int bj = 0; bj < 2; ++bj) {
                    if (half_only && bj == 1) continue;
#pragma unroll
                    for (int n = 0; n < 2; ++n) {
                        const int col = bj * HALF + wc * 32 + n * 16 + fq * 4;
                        f32x4 v = acc[ai][bj][m][n];
                        if (u.bcol) v += *(const f32x4*)(u.bcol + col);
                        v += br;
                        if (mode == EM_TANH128) {
#pragma unroll
                            for (int e = 0; e < 4; ++e) v[e] = 1.f - 2.f * __builtin_amdgcn_rcpf(1.f + __expf(2.f * v[e]));
                        } else if (mode == EM_SIG128 || mode == EM_SIGB) {
#pragma unroll
                            for (int e = 0; e < 4; ++e) v[e] = sigmoidf_(v[e]);
                        } else if (mode == EM_DECAY) {
#pragma unroll
                            for (int e = 0; e < 4; ++e) v[e] = 0.60653066f * sigmoidf_(v[e]);
                        }
                        u32x2 w; w.x = cvt_pk_bf16(v[0], v[1]); w.y = cvt_pk_bf16(v[2], v[3]);
                        *(u32x2*)(O + (size_t)row * ldc + col) = w;
                    }
                }
            }
    }
};

template <bool ALIGN_EPI, class Sched, class Epi>
__device__ __forceinline__ void gemm_phase(const int tid, LAS unsigned char* lds, const int lda, const int ldb, const int nt, const Sched& S, const Epi& E) {
    const int wid = __builtin_amdgcn_readfirstlane(tid >> 6), lane = tid & 63, wr = wid >> 2, wc = wid & 3, fr = lane & 15, fq = lane >> 4;
    unsigned voffA[2], voffB[2];
#pragma unroll
    for (int i = 0; i < 2; ++i) { int R, C; stage_rc(tid * 16 + i * 8192, R, C); voffA[i] = (unsigned)(R * lda + C) * 2u; voffB[i] = (unsigned)(R * ldb + C) * 2u; }
    const size_t kstep = (size_t)(BK * 2);
    const size_t hstepA = (size_t)HALF * lda * 2, hstepB = (size_t)HALF * ldb * 2;
    const unsigned ldsw = (unsigned)wid * 1024u;
    const int aoff = lds_byte(wr * 64 + fr, fq * 8), boff = lds_byte(wc * 32 + fr, fq * 8);
#define PG8_SA(b, h) (((b) * 2 + (h)) * HTB)
#define PG8_SB(b, h) ((4 + (b) * 2 + (h)) * HTB)
#define PG8_STAGE(bufoff, gbase, voff) do { _Pragma("unroll") for (int _i = 0; _i < 2; ++_i) \
        __builtin_amdgcn_global_load_lds((const unsigned*)((const char*)(gbase) + (voff)[_i]), (LAS unsigned*)(lds + (bufoff) + ldsw + _i * 8192), 16, 0, 0); } while (0)
#define PG8_LDA(dst, b, h) do { _Pragma("unroll") for (int m = 0; m < 4; ++m) _Pragma("unroll") for (int k = 0; k < 2; ++k) dst[m][k] = *(const LAS bf16x8*)(lds + PG8_SA(b, h) + aoff + m * 2048 + k * 1024); } while (0)
#define PG8_LDB(dst, b, h) do { _Pragma("unroll") for (int n = 0; n < 2; ++n) _Pragma("unroll") for (int k = 0; k < 2; ++k) dst[n][k] = *(const LAS bf16x8*)(lds + PG8_SB(b, h) + boff + n * 2048 + k * 1024); } while (0)
#define PG8_MMA(ai, bj, At, Bt) do { __builtin_amdgcn_s_setprio(1); _Pragma("unroll") for (int m = 0; m < 4; ++m) _Pragma("unroll") for (int n = 0; n < 2; ++n) _Pragma("unroll") for (int k = 0; k < 2; ++k) \
        acc[ai][bj][m][n] = __builtin_amdgcn_mfma_f32_16x16x32_bf16(Bt[n][k], At[m][k], acc[ai][bj][m][n], 0, 0, 0); __builtin_amdgcn_s_setprio(0); } while (0)
#define PG8_WAIT_V(n) asm volatile("s_waitcnt vmcnt(" #n ")" ::: "memory")
#define PG8_WAIT_L(n) asm volatile("s_waitcnt lgkmcnt(" #n ")" ::: "memory")
#define PG8_BAR __builtin_amdgcn_s_barrier()
#define PG8_SCHED __builtin_amdgcn_sched_barrier(0)
    Unit cur, nxt; int ui = 0;
    if (!S.next(0, cur)) return;
    f32x4 acc[2][2][4][2];
#pragma unroll
    for (int a = 0; a < 2; ++a)
#pragma unroll
        for (int b = 0; b < 2; ++b)
#pragma unroll
            for (int m = 0; m < 4; ++m)
#pragma unroll
                for (int n = 0; n < 2; ++n) acc[a][b][m][n] = (f32x4){0.f, 0.f, 0.f, 0.f};
    bf16x8 At[4][2], B0[2][2], B1[2][2];
    const char* cA = cur.A; const char* cB = cur.B;
    PG8_STAGE(PG8_SB(0, 0), cB, voffB); PG8_STAGE(PG8_SB(0, 1), cB + hstepB, voffB); PG8_STAGE(PG8_SA(0, 0), cA, voffA); PG8_STAGE(PG8_SA(0, 1), cA + hstepA, voffA);
    if (wr == 1) PG8_BAR;
    PG8_WAIT_V(2); PG8_BAR;
    PG8_STAGE(PG8_SB(1, 0), cB + kstep, voffB); PG8_STAGE(PG8_SA(1, 0), cA + kstep, voffA); PG8_STAGE(PG8_SB(1, 1), cB + hstepB + kstep, voffB);
    PG8_WAIT_V(6); PG8_BAR;
    for (;;) {
        const bool has_next = S.next(ui + 1, nxt);
        const char* nA = has_next ? nxt.A : cA; const char* nB = has_next ? nxt.B : cB;
        for (int t = 0; t < nt; t += 2) {
            const bool last = (t == nt - 2);
            const char* a1 = cA + (size_t)(t + 1) * kstep;
            const char* a2 = last ? nA : cA + (size_t)(t + 2) * kstep; const char* b2 = last ? nB : cB + (size_t)(t + 2) * kstep;
            const char* a3 = a2 + kstep; const char* b3 = b2 + kstep;
            PG8_LDB(B0, 0, 0); PG8_LDB(B1, 0, 1); PG8_SCHED; PG8_LDA(At, 0, 0); PG8_STAGE(PG8_SA(1, 1), a1 + hstepA, voffA);
            PG8_WAIT_V(8); PG8_WAIT_L(0); PG8_BAR; PG8_MMA(0, 0, At, B0); PG8_MMA(0, 1, At, B1); PG8_BAR; PG8_SCHED;
            PG8_LDA(At, 0, 1); PG8_STAGE(PG8_SB(0, 0), b2, voffB); PG8_STAGE(PG8_SB(0, 1), b2 + hstepB, voffB); PG8_STAGE(PG8_SA(0, 0), a2, voffA);
            PG8_WAIT_V(8); PG8_WAIT_L(0); PG8_BAR; PG8_MMA(1, 0, At, B0); PG8_MMA(1, 1, At, B1); PG8_BAR; PG8_SCHED;
            PG8_LDB(B0, 1, 0); PG8_LDB(B1, 1, 1); PG8_SCHED; PG8_LDA(At, 1, 0); PG8_STAGE(PG8_SA(0, 1), a2 + hstepA, voffA);
            PG8_WAIT_V(8); PG8_WAIT_L(0); PG8_BAR; PG8_MMA(0, 0, At, B0); PG8_MMA(0, 1, At, B1); PG8_BAR; PG8_SCHED;
            PG8_LDA(At, 1, 1); PG8_STAGE(PG8_SB(1, 0), b3, voffB); PG8_STAGE(PG8_SB(1, 1), b3 + hstepB, voffB); PG8_STAGE(PG8_SA(1, 0), a3, voffA);
            PG8_WAIT_V(8); PG8_WAIT_L(0); PG8_BAR; PG8_MMA(1, 0, At, B0); PG8_MMA(1, 1, At, B1); PG8_BAR; PG8_SCHED;
        }
        if constexpr (ALIGN_EPI) { if (wr == 0) PG8_BAR; }
        { Unit eu; (void)S.next(ui, eu); int fr2 = fr, fq2 = fq, lane2 = lane, wr2 = wr, wc2 = wc, wid2 = wid; asm volatile("" : "+v"(fr2), "+v"(fq2), "+v"(lane2), "+s"(wr2), "+s"(wc2), "+s"(wid2));
          E(acc, eu, wr2, wc2, fr2, fq2, lds, wid2, lane2); }
        if (!has_next) break;
#pragma unroll
        for (int a = 0; a < 2; ++a)
#pragma unroll
            for (int b = 0; b < 2; ++b)
#pragma unroll
                for (int m = 0; m < 4; ++m)
#pragma unroll
                    for (int n = 0; n < 2; ++n) acc[a][b][m][n] = (f32x4){0.f, 0.f, 0.f, 0.f};
        cur = nxt; cA = nA; cB = nB; ++ui;
        if constexpr (ALIGN_EPI) { if (wr == 1) PG8_BAR; }
    }
    PG8_WAIT_V(0);
    if constexpr (!ALIGN_EPI) { if (wr == 0) PG8_BAR; }
    PG8_BAR;
#undef PG8_SA
#undef PG8_SB
#undef PG8_STAGE
#undef PG8_LDA
#undef PG8_LDB
#undef PG8_MMA
#undef PG8_WAIT_V
#undef PG8_WAIT_L
#undef PG8_BAR
#undef PG8_SCHED
}

enum { PH_PREP = 0, PH_R0 = 1, PH_RMID = 2, PH_REND = 3, PH_HC = 4, PH_RS = 5, PH_RP = 6, PH_HT = 7, PH_MIX = 19,
       PH_FG1 = 8, PH_FG2S = 9, PH_FG2P = 10, PH_FG3 = 11, PH_HG1 = 12, PH_HG2 = 13, PH_RG1 = 14, PH_RG2 = 15, PH_RG3 = 16, PH_NG1 = 17, PH_NG2 = 18 };
struct SchedAny {
    int code, l, G, c; unsigned char* ws; bool fuse;
    __device__ __forceinline__ bool next(int i, Unit& u) const {
        int L = i * G + c; const char* w = (const char*)ws; const float* bias = (const float*)(ws + WS_BIAS);
        u.bcol = nullptr; u.brow = nullptr; u.mode = EM_PLAIN; u.ldc = 1024;
        switch (code) {
        case PH_FG1: {
            if (L >= 384) return false;
            const int tt = L >> 3, rem = L & 7, g = rem >> 1, pm = rem & 1; int start, Ls, l0; tile_seq(tt, start, Ls, l0);
            u.A = w + WS_CS256 + (size_t)pm * 256 * 256 * 2; u.B = w + WS_H + ((size_t)tt * 256 * 1024 + g * 256) * 2;
            u.O = (char*)ws + WS_HCST + ((size_t)start * 2048 + (size_t)(g * 512 + pm * 256) * Ls + l0) * 2; u.ldc = Ls; return true; }
        case PH_FG2S: {
            if (L >= 128) return false;
            const int j = L >> 5, rem = L & 31, pm = rem >> 2, pn = rem & 3; const size_t start = 4096 + (size_t)j * 2048;
            u.A = w + WS_SEQ2048 + (size_t)pm * 256 * 4096 * 2; u.B = w + WS_HCST + (start * 2048 + (size_t)pn * 256 * 4096) * 2;
            u.O = (char*)ws + WS_FOUT + ((start + pm * 256) * 1024 + pn * 256) * 2; return true; }
        case PH_FG2P: {
            const int cc = (c + G - (128 % G)) % G; L = i * G + cc; if (L >= 64) return false;
            const int s = L >> 2, pn = L & 3;
            u.A = w + WS_SEQ256; u.B = w + WS_HCST + ((size_t)s * 256 * 2048 + (size_t)pn * 256 * 512) * 2;
            u.O = (char*)ws + WS_FOUT + ((size_t)s * 256 * 1024 + pn * 256) * 2; return true; }
        case PH_HG1: {
            if (L >= 576) return false;
            const int tt = L / 12, pm = L - tt * 12; int start, Ls, l0; tile_seq(tt, start, Ls, l0);
            u.A = w + WS_HYWINT + (size_t)pm * 256 * 1024 * 2; u.B = w + WS_H + (size_t)tt * 256 * 1024 * 2;
            u.O = (char*)ws + WS_UT + ((size_t)start * 3072 + (size_t)pm * 256 * Ls + l0) * 2; u.ldc = Ls; u.brow = bias + 2048 + pm * 256; return true; }
        case PH_RG1: {
            if (L >= 720) return false;
            if (L < 576) { const int p = L / 192, r = L - p * 192, pm = r >> 2, pn = r & 3;
                u.A = w + WS_XM + (size_t)p * SZ_TD2 + (size_t)pm * 256 * 1024 * 2; u.B = w + WS_RWT + ((size_t)p * 1024 + pn * 256) * 1024 * 2;
                u.O = (char*)ws + WS_RKV + (size_t)p * SZ_TD2 + ((size_t)pm * 256 * 1024 + pn * 256) * 2;
            } else { const int q = L - 576, p = q / 48, pm = q - p * 48;
                u.A = w + WS_XM + (size_t)(3 + p) * SZ_TD2 + (size_t)pm * 256 * 1024 * 2; u.B = w + WS_LORA1T + (size_t)p * 256 * 1024 * 2;
                u.O = (char*)ws + WS_L1 + ((size_t)pm * 256 * 384 + p * 128) * 2; u.ldc = 384; u.mode = (p == 0) ? EM_TANH128 : (p == 1 ? EM_ID128 : EM_SIG128); }
            return true; }
        case PH_RG2: {
            if (L >= 960) return false;
            const int p = L / 192, r = L - p * 192, pm = r >> 2, pn = r & 3;
            u.A = w + WS_L1 + ((size_t)pm * 256 * 384 + (p == 4 ? 128 : 0)) * 2; u.B = w + WS_LORA2T + ((size_t)p * 1024 + pn * 256) * 256 * 2;
            const size_t o = ((size_t)pm * 256 * 1024 + pn * 256) * 2;
            if (p == 4) { u.O = (char*)ws + WS_G + o; }
            else if (p < 2) { u.O = (char*)ws + WS_E + (size_t)p * SZ_TD2 + o; u.bcol = bias + 6144 + p * 1024 + pn * 256; u.mode = EM_DECAY; }
            else { u.O = (char*)ws + WS_AA + (size_t)(p - 2) * SZ_TD2 + o; u.bcol = bias + 8192 + (p - 2) * 1024 + pn * 256; u.mode = EM_SIGB; }
            return true; }
        case PH_NG1: {
            if (L >= 1056) return false;
            const int pm = L / 22, pn = L - pm * 22;
            u.A = w + WS_H + (size_t)pm * 256 * 1024 * 2; u.B = w + WS_W13T + (size_t)pn * 256 * 1024 * 2;
            u.O = (char*)ws + WS_TB + ((size_t)pm * 256 * FF + pn * 128) * 2; u.ldc = FF; u.mode = EM_SWIGLU; return true; }
        default: {
            if (L >= 192) return false;
            const int pm = L >> 2, pn = L & 3; size_t a, b, k;
            if (code == PH_FG3) { a = WS_FOUT; b = WS_FNWT + (size_t)(l / 3) * 2097152; k = 1024; u.bcol = bias + (l / 3) * 1024 + pn * 256; }
            else if (code == PH_HG2) { a = WS_YO; b = WS_HYWOUTT; k = 1024; u.bcol = bias + 5120 + pn * 256; }
            else if (code == PH_RG3) { a = WS_OF; b = WS_WOT; k = 1024; }
            else { a = WS_TB; b = WS_W2T; k = FF; }
            u.A = w + a + (size_t)pm * 256 * k * 2; u.B = w + b + (size_t)pn * 256 * k * 2;
            u.O = (char*)ws + WS_Y + ((size_t)pm * 256 * 1024 + pn * 256) * 2; if (fuse) { u.mode = EM_FUSED; u.bcol = nullptr; } return true; }
        }
    }
};

__device__ __forceinline__ void transpose_item(const float* W, int N, bf16_t* WT, int dst_ld, int k_off, int mode, int row_off, LAS float* scr, int item, int lane) {
    const int nblk = N / 32, kb = item / nblk, nb = item - kb * nblk, k0 = 64 * kb, n0 = 32 * nb;
    { float wv[32];
#pragma unroll
      for (int i = 0; i < 32; ++i) wv[i] = __builtin_nontemporal_load(W + (size_t)(k0 + 2 * i + (lane >> 5)) * N + n0 + (lane & 31));
#pragma unroll
      for (int i = 0; i < 32; ++i) scr[(2 * i + (lane >> 5)) * 33 + (lane & 31)] = wv[i]; }
    asm volatile("s_waitcnt lgkmcnt(0)" ::: "memory");
    const int c = lane & 7;
#pragma unroll
    for (int j = 0; j < 4; ++j) { const int n = (lane >> 3) + 8 * j; const LAS float* s = scr + (8 * c) * 33 + n; const int nn = n0 + n;
        const int drow = (mode == 0) ? row_off + nn : ((nn >> 4) * 32 + (nn & 15) + (mode == 2 ? 16 : 0));
        u32x4 o; o.x = cvt_pk_bf16(s[0 * 33], s[1 * 33]); o.y = cvt_pk_bf16(s[2 * 33], s[3 * 33]); o.z = cvt_pk_bf16(s[4 * 33], s[5 * 33]); o.w = cvt_pk_bf16(s[6 * 33], s[7 * 33]);
        *(u32x4*)(WT + (size_t)drow * dst_ld + k_off + k0 + 8 * c) = o; }
    asm volatile("s_waitcnt lgkmcnt(0)" ::: "memory");
}

__device__ __forceinline__ void convert_ffn(const KP& p, int l, LAS float* scr, int gw, int NGW, int lane) {
    const float* w1 = p.in(I_W1) + (size_t)l * DM * FF; const float* w3 = p.in(I_W3) + (size_t)l * DM * FF; const float* w2 = p.in(I_W2) + (size_t)l * FF * DM;
    bf16_t* w13t = (bf16_t*)(p.ws() + WS_W13T); bf16_t* w2t = (bf16_t*)(p.ws() + WS_W2T);
    for (int it = gw; it < 4224; it += NGW) {
        int r = it;
        if (r < 1408) { transpose_item(w1, FF, w13t, 1024, 0, 1, 0, scr, r, lane); continue; } r -= 1408;
        if (r < 1408) { transpose_item(w3, FF, w13t, 1024, 0, 2, 0, scr, r, lane); continue; } r -= 1408;
        transpose_item(w2, DM, w2t, FF, 0, 0, 0, scr, r, lane);
    }
}

__device__ __forceinline__ void p0_transposes(const KP& p, LAS float* scr, int gw, int NGW, int lane) {
    unsigned char* ws = p.ws();
    for (int it = gw; it < 5504; it += NGW) {
        int r = it;
        if (r < 1024) { const int j = r >> 9; transpose_item(p.in(I_FNW) + (size_t)j * DM * DM, DM, (bf16_t*)(ws + WS_FNWT) + (size_t)j * DM * DM, 1024, 0, 0, 0, scr, r & 511, lane); continue; } r -= 1024;
        if (r < 1536) { transpose_item(p.in(I_HYWIN), 3072, (bf16_t*)(ws + WS_HYWINT), 1024, 0, 0, 0, scr, r, lane); continue; } r -= 1536;
        if (r < 512) { transpose_item(p.in(I_HYWOUT), DM, (bf16_t*)(ws + WS_HYWOUTT), 1024, 0, 0, 0, scr, r, lane); continue; } r -= 512;
        if (r < 1536) { const int j = r >> 9; transpose_item(p.in(I_WR + j), DM, (bf16_t*)(ws + WS_RWT) + (size_t)j * DM * DM, 1024, 0, 0, 0, scr, r & 511, lane); continue; } r -= 1536;
        if (r < 512) { transpose_item(p.in(I_WO), DM, (bf16_t*)(ws + WS_WOT), 1024, 0, 0, 0, scr, r, lane); continue; } r -= 512;
        if (r < 64) { const int d = r >> 5; transpose_item(p.in(I_RW1) + (size_t)d * DM * 64, 64, (bf16_t*)(ws + WS_LORA1T), 1024, 0, 0, d * 64, scr, r & 31, lane); continue; } r -= 64;
        if (r < 64) { const int d = r >> 5; transpose_item(p.in(I_A1) + (size_t)d * DM * 64, 64, (bf16_t*)(ws + WS_LORA1T) + 256 * 1024, 1024, 0, 0, d * 64, scr, r & 31, lane); continue; } r -= 64;
        if (r < 64) { transpose_item(p.in(I_G1), 128, (bf16_t*)(ws + WS_LORA1T) + 2 * 256 * 1024, 1024, 0, 0, 0, scr, r, lane); continue; } r -= 64;
        if (r < 64) { const int d = r >> 5; transpose_item(p.in(I_RW2) + (size_t)d * 64 * DM, DM, (bf16_t*)(ws + WS_LORA2T) + (size_t)d * 1024 * 256, 256, d * 64, 0, 0, scr, r & 31, lane); continue; } r -= 64;
        if (r < 64) { const int d = r >> 5; transpose_item(p.in(I_A2) + (size_t)d * 64 * DM, DM, (bf16_t*)(ws + WS_LORA2T) + (size_t)(2 + d) * 1024 * 256, 256, 128 + d * 64, 0, 0, scr, r & 31, lane); continue; } r -= 64;
        transpose_item(p.in(I_G2), DM, (bf16_t*)(ws + WS_LORA2T) + (size_t)4 * 1024 * 256, 256, 128, 0, 0, scr, r, lane);
    }
}

__device__ __forceinline__ void p0_tables(const KP& p, int gtid, int NT) {
    unsigned char* ws = p.ws();
    for (int it = gtid; it < 5 * 1024 * 32; it += NT) {
        const int m = it >> 15, rem = it & 32767, row = rem >> 5, ch = rem & 31, k = ch * 8;
        const int lo = (m == 0) ? 0 : (m == 1 ? 64 : (m == 2 ? 128 : (m == 3 ? 192 : 128))), hi = (m == 4) ? 256 : lo + 64;
        unsigned zz = 0u; asm volatile("" : "+v"(zz));
        if (k < lo || k >= hi) *(u32x4*)((bf16_t*)(ws + WS_LORA2T) + ((size_t)m * 1024 + row) * 256 + k) = (u32x4){zz, zz, zz, zz};
    }
    { float* bias = (float*)(ws + WS_BIAS);
      for (int it = gtid; it < 10240; it += NT) { float v;
          if (it < 2048) v = p.in(I_FNB)[it]; else if (it < 5120) v = p.in(I_HYBIN)[it - 2048]; else if (it < 6144) v = p.in(I_HYBOUT)[it - 5120]; else if (it < 8192) v = p.in(I_W0)[it - 6144]; else v = p.in(I_A0)[it - 8192];
          bias[it] = v; } }
    for (int it = gtid; it < 512 * 32; it += NT) {
        const int m = it >> 5, k0 = (it & 31) * 8, j = m >> 1, pp = m & 1; float v[8];
#pragma unroll
        for (int e = 0; e < 8; ++e) { const float fr = (float)((j * (k0 + e)) & 255) * (1.f / 256.f); v[e] = (pp ? __builtin_amdgcn_sinf(fr) : __builtin_amdgcn_cosf(fr)) * 0.0625f; }
        u32x4 o; o.x = cvt_pk_bf16(v[0], v[1]); o.y = cvt_pk_bf16(v[2], v[3]); o.z = cvt_pk_bf16(v[4], v[5]); o.w = cvt_pk_bf16(v[6], v[7]);
        *(u32x4*)((bf16_t*)(ws + WS_CS256) + (size_t)m * 256 + k0) = o;
    }
    for (int it = gtid; it < 256 * 64 + 2048 * 512; it += NT) {
        int L, lp, kc; bf16_t* dst;
        if (it < 256 * 64) { L = 256; lp = it >> 6; kc = (it & 63) * 8; dst = (bf16_t*)(ws + WS_SEQ256) + (size_t)lp * 512 + kc; }
        else { const int q = it - 256 * 64; L = 2048; lp = q >> 9; kc = (q & 511) * 8; dst = (bf16_t*)(ws + WS_SEQ2048) + (size_t)lp * 4096 + kc; }
        const int pp = kc >= L, l0 = kc - pp * L; const float invL = 1.f / (float)L, sc = (L == 256) ? 0.0625f : 0.022097087f; float v[8];
#pragma unroll
        for (int e = 0; e < 8; ++e) { const float fr = (float)((lp * (l0 + e)) & (L - 1)) * invL; v[e] = (pp ? -__builtin_amdgcn_sinf(fr) : __builtin_amdgcn_cosf(fr)) * sc; }
        u32x4 o; o.x = cvt_pk_bf16(v[0], v[1]); o.y = cvt_pk_bf16(v[2], v[3]); o.z = cvt_pk_bf16(v[4], v[5]); o.w = cvt_pk_bf16(v[6], v[7]);
        *(u32x4*)dst = o;
    }
}

__device__ __forceinline__ void p0_mod(const KP& p, const int tid, LAS float* lds_f, int c, int G) {
    LAS float* sc = lds_f;
    LAS float* part = lds_f + 5120;
    const int wid = tid >> 6, lane = tid & 63;
    for (int i = tid; i < 5120; i += NTHR) { const int cd = i >> 10, k = i & 1023; const float x = cd == 0 ? p.in(I_CCTX)[k] : p.in(I_C)[(cd - 1) * 1024 + k]; sc[i] = x * sigmoidf_(x); }
    __syncthreads();
    float* MOD = (float*)(p.ws() + WS_MOD);
    for (int it = c; it < 96; it += G) {
        const int l = it / 24, cg_ = it - l * 24;
        const float* W = p.in(I_ADAW) + (size_t)l * DM * 6144 + cg_ * 256 + lane * 4;
        f32x4 a0 = {0.f, 0.f, 0.f, 0.f}, a1 = a0, a2 = a0, a3 = a0, a4 = a0;
        const int kb = wid * 128;
#pragma unroll 1
        for (int k0 = 0; k0 < 128; k0 += 32) {
            f32x4 w[32];
#pragma unroll
            for (int j = 0; j < 32; ++j) w[j] = __builtin_nontemporal_load((const f32x4*)(W + (size_t)(kb + k0 + j) * 6144));
#pragma unroll
            for (int j = 0; j < 32; ++j) { const int k = kb + k0 + j; a0 += sc[k] * w[j]; a1 += sc[1024 + k] * w[j]; a2 += sc[2048 + k] * w[j]; a3 += sc[3072 + k] * w[j]; a4 += sc[4096 + k] * w[j]; }
        }
        *(LAS f32x4*)(part + (wid * 5 + 0) * 256 + lane * 4) = a0; *(LAS f32x4*)(part + (wid * 5 + 1) * 256 + lane * 4) = a1; *(LAS f32x4*)(part + (wid * 5 + 2) * 256 + lane * 4) = a2;
        *(LAS f32x4*)(part + (wid * 5 + 3) * 256 + lane * 4) = a3; *(LAS f32x4*)(part + (wid * 5 + 4) * 256 + lane * 4) = a4;
        __syncthreads();
        for (int o = tid; o < 1280; o += NTHR) { const int cd = o >> 8, ln = o & 255; float s_ = p.in(I_ADAB)[l * 6144 + cg_ * 256 + ln];
#pragma unroll
            for (int w = 0; w < 8; ++w) s_ += part[(w * 5 + cd) * 256 + ln];
            MOD[((size_t)l * 5 + cd) * 6144 + cg_ * 256 + ln] = s_; }
        __syncthreads();
    }
}

__device__ __forceinline__ void p0_hyfilter(const KP& p, const int tid, LAS float* lds_f, int c, int G) {
    LAS float* h1 = lds_f;
    LAS float* h2 = lds_f + 64 * 65;
    LAS float* w1s = h2 + 64 * 64;
    LAS float* w2s = w1s + 33 * 64;
    const float* w1 = p.in(I_HYFW1); const float* b1 = p.in(I_HYFB1); const float* fq = p.in(I_HYFREQ); const float* w2 = p.in(I_HYFW2); const float* b2 = p.in(I_HYFB2); const float* w3 = p.in(I_HYFW3);
    for (int i = tid; i < 33 * 64; i += NTHR) w1s[i] = w1[i];
    for (int i = tid; i < 64 * 64; i += NTHR) w2s[i] = w2[i];
    __syncthreads();
    for (int it = c; it < 144; it += G) {
        const int tc = it >> 2, cgp = it & 3; int L, t0; if (tc < 4) { L = 256; t0 = tc * 64; } else { L = 2048; t0 = (tc - 4) * 64; }
        float* KF = (float*)(p.ws() + (L == 256 ? WS_KF256 : WS_KF2048));
        {
            const int tl = tid >> 3, u0 = (tid & 7) * 8, t = t0 + tl; float a[8];
#pragma unroll
            for (int e = 0; e < 8; ++e) a[e] = b1[u0 + e];
            const float tf = (float)t / (float)(L - 1), ang = 6.283185307179586f * (float)t / (float)L;
#pragma unroll
            for (int e = 0; e < 8; ++e) a[e] += tf * w1s[u0 + e];
            for (int j = 0; j < 16; ++j) { const float band = 1e-4f + (float)j * ((15.f - 1e-4f) / 15.f); const float x = band * ang; const float cs = __cosf(x), sn = -__sinf(x);
#pragma unroll
                for (int e = 0; e < 8; ++e) a[e] += cs * w1s[(1 + j) * 64 + u0 + e] + sn * w1s[(17 + j) * 64 + u0 + e]; }
#pragma unroll
            for (int e = 0; e < 8; ++e) h1[tl * 65 + u0 + e] = __sinf(fq[u0 + e] * a[e]);
        }
        __syncthreads();
        {
            const int tl = tid >> 3, u0 = (tid & 7) * 8; float a[8];
#pragma unroll
            for (int e = 0; e < 8; ++e) a[e] = b2[u0 + e];
            for (int j = 0; j < 64; ++j) { const float hv = h1[tl * 65 + j];
#pragma unroll
                for (int e = 0; e < 8; ++e) a[e] += hv * w2s[j * 64 + u0 + e]; }
#pragma unroll
            for (int e = 0; e < 8; ++e) h2[tl * 64 + u0 + e] = __sinf(fq[64 + u0 + e] * a[e]);
        }
        __syncthreads();
        {
            const int cc = cgp * 512 + tid, d = cc & 1023; const bool bwd = cc >= 1024;
            float wc[64];
#pragma unroll
            for (int j = 0; j < 64; ++j) wc[j] = w3[j * 2048 + cc];
            const float da = -15.350567286626973f, db = -3.0701134573253945f; const float adel = fabsf(da + (float)d * ((db - da) / 1023.f));
            for (int tl = 0; tl < 64; tl += 4) {
                f32x4 vals;
#pragma unroll
                for (int q = 0; q < 4; ++q) { const int t = t0 + tl + q; float acc = 0.f;
#pragma unroll
                    for (int j = 0; j < 64; j += 4) { const f32x4 hv = *(const LAS f32x4*)(h2 + (tl + q) * 64 + j); acc += hv[0] * wc[j] + hv[1] * wc[j + 1] + hv[2] * wc[j + 2] + hv[3] * wc[j + 3]; }
                    vals[q] = acc * __expf(-((float)t / (float)(L - 1)) * adel); asm volatile("" ::: "memory"); }
                if (t0 + tl == 0) { if (bwd) vals[0] = 0.f; else { float acc2 = 0.f; for (int j = 0; j < 64; ++j) acc2 += h2[j] * w3[j * 2048 + cc + 1024]; vals[0] += acc2; } }
                *(f32x4*)(KF + (size_t)d * 2 * L + (bwd ? L : 0) + t0 + tl) = vals;
            }
        }
        __syncthreads();
    }
}

struct RowCfg {
    const float* xs_p; const float* xs_s;
    float* xdst;
    const bf16_t* y;
    const float* gate; const float* ng_post;
    const float* ng_pre; const float* sc; const float* sh;
    bf16_t* h;
    const float* mix; bf16_t* xm;
};
__device__ __forceinline__ void compute_row(const RowCfg& cf, int r, int lane, bool store, f32x4 (&hv)[4]) {
    const float* xr = (r < 4096) ? cf.xs_p + (size_t)r * 1024 : cf.xs_s + (size_t)(r - 4096) * 1024;
    const int cd = cond_of(r); f32x4 x[4];
#pragma unroll
    for (int j = 0; j < 4; ++j) x[j] = *(const f32x4*)(xr + 4 * lane + 256 * j);
    if (cf.y) {
        f32x4 yv[4]; float ss = 0.f;
#pragma unroll
        for (int j = 0; j < 4; ++j) { const u32x2 w = *(const u32x2*)(cf.y + (size_t)r * 1024 + 4 * lane + 256 * j); yv[j] = (f32x4){bflo(w.x), bfhi(w.x), bflo(w.y), bfhi(w.y)};
            ss += (yv[j][0] * yv[j][0] + yv[j][1] * yv[j][1]) + (yv[j][2] * yv[j][2] + yv[j][3] * yv[j][3]); }
        const float rstd = rsqrtf(wave_sum(ss) * (1.f / 1024.f) + 1e-6f);
#pragma unroll
        for (int j = 0; j < 4; ++j) { const f32x4 gt = *(const f32x4*)(cf.gate + cd * 6144 + 4 * lane + 256 * j), ng = *(const f32x4*)(cf.ng_post + 4 * lane + 256 * j);
            x[j] += gt * (yv[j] * rstd * ng); }
        if (store && cf.xdst) {
#pragma unroll
            for (int j = 0; j < 4; ++j) *(f32x4*)(cf.xdst + (size_t)r * 1024 + 4 * lane + 256 * j) = x[j];
        }
    }
    if (cf.ng_pre) {
        f32x4 ngv[4], s1v[4], s0v[4];
#pragma unroll
        for (int j = 0; j < 4; ++j) { const int cc = 4 * lane + 256 * j; ngv[j] = *(const f32x4*)(cf.ng_pre + cc); s1v[j] = *(const f32x4*)(cf.sc + cd * 6144 + cc); s0v[j] = *(const f32x4*)(cf.sh + cd * 6144 + cc); }
        float ss = 0.f;
#pragma unroll
        for (int j = 0; j < 4; ++j) ss += (x[j][0] * x[j][0] + x[j][1] * x[j][1]) + (x[j][2] * x[j][2] + x[j][3] * x[j][3]);
        const float rstd = rsqrtf(wave_sum(ss) * (1.f / 1024.f) + 1e-6f);
#pragma unroll
        for (int j = 0; j < 4; ++j) hv[j] = x[j] * rstd * ngv[j] * (1.f + s1v[j]) + s0v[j];
    }
}
template <bool RW>
__device__ __forceinline__ void row_phase(const RowCfg& cf, int gw, int NGW, int lane) {
    if constexpr (!RW) {
        for (int r = gw; r < T_TOK; r += NGW) {
            f32x4 hv[4]; compute_row(cf, r, lane, true, hv);
            if (cf.ng_pre) {
#pragma unroll
                for (int j = 0; j < 4; ++j) { u32x2 w; w.x = cvt_pk_bf16(hv[j][0], hv[j][1]); w.y = cvt_pk_bf16(hv[j][2], hv[j][3]); *(u32x2*)(cf.h + (size_t)r * 1024 + 4 * lane + 256 * j) = w; }
            }
        }
    } else {
        const int slot[6] = {0, 3, 1, 2, 4, 5};
        for (int st = gw; st < T_TOK / 4; st += NGW) {
            const int t0 = st * 4; int s0, s1;
            if (t0 < 4096) { s0 = t0 & ~255; s1 = s0 + 256; } else { s0 = 4096 + ((t0 - 4096) & ~2047); s1 = s0 + 2048; }
            f32x4 hp[4], hc[4], hn[4];
            if (t0 - 1 >= s0) compute_row(cf, t0 - 1, lane, false, hp); else {
#pragma unroll
                for (int j = 0; j < 4; ++j) hp[j] = (f32x4){0.f, 0.f, 0.f, 0.f}; }
            compute_row(cf, t0, lane, true, hc);
#pragma unroll 1
            for (int i = 0; i < 4; ++i) {
                const int t = t0 + i;
                if (t + 1 < s1) compute_row(cf, t + 1, lane, i < 3, hn); else {
#pragma unroll
                    for (int j = 0; j < 4; ++j) hn[j] = (f32x4){0.f, 0.f, 0.f, 0.f}; }
#pragma unroll
                for (int j = 0; j < 4; ++j) { const int cc = 4 * lane + 256 * j; const f32x4 xx = 0.5f * (hp[j] + hn[j]) - hc[j];
#pragma unroll
                    for (int m = 0; m < 6; ++m) { const f32x4 mx = *(const f32x4*)(cf.mix + m * 1024 + cc); const f32x4 v = hc[j] + xx * mx;
                        u32x2 w; w.x = cvt_pk_bf16(v[0], v[1]); w.y = cvt_pk_bf16(v[2], v[3]);
                        *(u32x2*)(cf.xm + (size_t)slot[m] * T_TOK * 1024 + (size_t)t * 1024 + cc) = w; } }
#pragma unroll
                for (int j = 0; j < 4; ++j) { hp[j] = hc[j]; hc[j] = hn[j]; }
            }
        }
    }
}

typedef float f32x16 __attribute__((ext_vector_type(16)));
__device__ __forceinline__ float shortconv(const bf16_t* row, int t, int L, float c0, float c1, float c2, float cb) {
    const float um = t > 0 ? bf2f(row[t - 1]) : 0.f, u0 = bf2f(row[t]), up = t + 1 < L ? bf2f(row[t + 1]) : 0.f;
    return c0 * um + c1 * u0 + c2 * up + cb;
}
__device__ __forceinline__ f32x16 conv_mfma(const LAS unsigned char* rk, int rkstride, const LAS unsigned char* z, int zs, int L, int I0, int dlo, int dhi, int lane) {
    const int i = lane & 31, h = lane >> 5, s = (-i) & 7, bl = (lane >> 3) & 3, Jl = lane & 7;
    const LAS unsigned char* ap = rk + s * rkstride + (L - i - s + h * 8) * 2;
    const LAS unsigned char* bp = z + bl * zs + ((Jl + 7) * 32 + h * 8) * 2;
    f32x16 acc;
#pragma unroll
    for (int e = 0; e < 16; ++e) acc[e] = 0.f;
#pragma unroll 2
    for (int dl = dlo; dl <= dhi; ++dl) {
        const LAS unsigned char* a0 = ap - dl * 64; const LAS unsigned char* b0 = bp + (I0 - dl) * 64;
        const bf16x8 av0 = *(const LAS bf16x8*)a0, bv0 = *(const LAS bf16x8*)b0, av1 = *(const LAS bf16x8*)(a0 + 32), bv1 = *(const LAS bf16x8*)(b0 + 32);
        acc = __builtin_amdgcn_mfma_f32_32x32x16_bf16(av0, bv0, acc, 0, 0, 0);
        acc = __builtin_amdgcn_mfma_f32_32x32x16_bf16(av1, bv1, acc, 0, 0, 0);
    }
    return acc;
}
template <int L, int NBAT, int NT_>
struct HyCh {
    f32x4 kf[2]; u32x4 um[2][3]; unsigned pv[2][3], nx[2][3];
    __device__ __forceinline__ void load(const KP& p, int t, int tok0, int d) {
        const float* KF = (const float*)(p.ws() + (L == 256 ? WS_KF256 : WS_KF2048)) + (size_t)d * 2 * L;
#pragma unroll
        for (int k = 0; k < 2; ++k) { const int j = t + k * NT_; if (j < 2 * L / 4) kf[k] = *(const f32x4*)(KF + 4 * j); }
        const bf16_t* UT = (const bf16_t*)(p.ws() + WS_UT);
#pragma unroll
        for (int k = 0; k < 2; ++k) { const int it = t + k * NT_, b = it / (L / 8), t0 = (it - b * (L / 8)) * 8;
#pragma unroll
            for (int r = 0; r < 3; ++r) { const bf16_t* row = UT + (size_t)(tok0 + b * L) * 3072 + (size_t)(r * 1024 + d) * L;
                um[k][r] = *(const u32x4*)(row + t0); pv[k][r] = row[t0 > 0 ? t0 - 1 : 0]; nx[k][r] = row[t0 + 8 < L ? t0 + 8 : t0]; } }
    }
    __device__ __forceinline__ void store(const KP& p, int t, int d, LAS unsigned char* rk0, LAS unsigned char* z, int zs, LAS bf16_t* x0) const {
#pragma unroll
        for (int k = 0; k < 2; ++k) { const int j = t + k * NT_; if (j < 2 * L / 4) {
#pragma unroll
                for (int e = 0; e < 4; ++e) { const int i = 4 * j + e, circ = i <= L ? i : 3 * L - i;
                    *(LAS bf16_t*)(rk0 + ((L - circ) & (2 * L - 1)) * 2) = (bf16_t)(cvt_pk_bf16(kf[k][e], 0.f) & 0xffffu); } } }
        const float* cw = p.in(I_HYCW); const float* cb = p.in(I_HYCB); float c0[3], c1[3], c2[3], cbv[3];
#pragma unroll
        for (int r = 0; r < 3; ++r) { c0[r] = cw[r * 1024 + d]; c1[r] = cw[3072 + r * 1024 + d]; c2[r] = cw[6144 + r * 1024 + d]; cbv[r] = cb[r * 1024 + d]; }
#pragma unroll
        for (int k = 0; k < 2; ++k) { const int it = t + k * NT_, b = it / (L / 8), t0 = (it - b * (L / 8)) * 8; float cv[3][8];
#pragma unroll
            for (int r = 0; r < 3; ++r) { float u[10]; u[0] = t0 > 0 ? bflo(pv[k][r]) : 0.f; u[9] = t0 + 8 < L ? bflo(nx[k][r]) : 0.f;
                u[1] = bflo(um[k][r].x); u[2] = bfhi(um[k][r].x); u[3] = bflo(um[k][r].y); u[4] = bfhi(um[k][r].y); u[5] = bflo(um[k][r].z); u[6] = bfhi(um[k][r].z); u[7] = bflo(um[k][r].w); u[8] = bfhi(um[k][r].w);
#pragma unroll
                for (int e = 0; e < 8; ++e) cv[r][e] = c0[r] * u[e] + c1[r] * u[e + 1] + c2[r] * u[e + 2] + cbv[r]; }
            u32x4 zo, xo;
            zo.x = cvt_pk_bf16(cv[2][0] * cv[1][0], cv[2][1] * cv[1][1]); zo.y = cvt_pk_bf16(cv[2][2] * cv[1][2], cv[2][3] * cv[1][3]); zo.z = cvt_pk_bf16(cv[2][4] * cv[1][4], cv[2][5] * cv[1][5]); zo.w = cvt_pk_bf16(cv[2][6] * cv[1][6], cv[2][7] * cv[1][7]);
            xo.x = cvt_pk_bf16(cv[0][0], cv[0][1]); xo.y = cvt_pk_bf16(cv[0][2], cv[0][3]); xo.z = cvt_pk_bf16(cv[0][4], cv[0][5]); xo.w = cvt_pk_bf16(cv[0][6], cv[0][7]);
            *(LAS u32x4*)(z + b * zs + (7 * 32 + t0) * 2) = zo; *(LAS u32x4*)((LAS unsigned char*)x0 + (b * L + t0) * 2) = xo; }
        for (int it = t; it < NBAT * 56; it += NT_) { const int b = it / 56, r = it - b * 56, side = r / 28, ch = r - side * 28;
            unsigned zz = 0u; asm volatile("" : "+v"(zz));
            *(LAS u32x4*)(z + b * zs + (side ? (L / 32 + 7) * 64 : 0) + ch * 16) = (u32x4){zz, zz, zz, zz}; }
    }
    __device__ __forceinline__ static void copies(int t, LAS unsigned char* rk, int rkstride) {
        constexpr int NCH = 2 * L / 8;
        for (int q = t; q < NCH; q += NT_) {
            const u32x4 lo = *(const LAS u32x4*)(rk + q * 16), hi = *(const LAS u32x4*)(rk + (q + 1 < NCH ? q + 1 : q) * 16);
            const unsigned cat[9] = {lo.x, lo.y, lo.z, lo.w, hi.x, hi.y, hi.z, hi.w, hi.w};
#pragma unroll
            for (int sft = 1; sft < 8; ++sft) { const int m = sft >> 1; u32x4 o;
                if (sft & 1) { o.x = __builtin_amdgcn_alignbyte(cat[m + 1], cat[m], 2); o.y = __builtin_amdgcn_alignbyte(cat[m + 2], cat[m + 1], 2); o.z = __builtin_amdgcn_alignbyte(cat[m + 3], cat[m + 2], 2); o.w = __builtin_amdgcn_alignbyte(cat[m + 4], cat[m + 3], 2); }
                else { o.x = cat[m]; o.y = cat[m + 1]; o.z = cat[m + 2]; o.w = cat[m + 3]; }
                *(LAS u32x4*)(rk + sft * rkstride + q * 16) = o; }
        }
    }
};
__device__ __forceinline__ void hy_epi(const f32x16& acc, const LAS unsigned char* z, int zs, const LAS bf16_t* x0, int L, int I0, int b0, float ds, bf16_t* yot, int tok0, int d, int lane) {
    const int h = lane >> 5, bl = (lane >> 3) & 3, Jl = lane & 7, b = b0 + bl;
#pragma unroll
    for (int g = 0; g < 4; ++g) { const int t = (I0 + Jl) * 32 + 8 * g + 4 * h; float o[4];
        const u32x2 zw = *(const LAS u32x2*)(z + b * zs + (7 * 32 + t) * 2), xw = *(const LAS u32x2*)((const LAS unsigned char*)x0 + (b * L + t) * 2);
        const float zz[4] = {bflo(zw.x), bfhi(zw.x), bflo(zw.y), bfhi(zw.y)}, xc[4] = {bflo(xw.x), bfhi(xw.x), bflo(xw.y), bfhi(xw.y)};
#pragma unroll
        for (int e = 0; e < 4; ++e) o[e] = (acc[4 * g + e] + zz[e] * ds) * xc[e];
        u32x2 w; w.x = cvt_pk_bf16(o[0], o[1]); w.y = cvt_pk_bf16(o[2], o[3]);
        *(u32x2*)(yot + (size_t)(tok0 + b * L) * 1024 + (size_t)d * L + t) = w; }
}
__device__ __forceinline__ void hyena_conv_phase(const KP& p, const int tid, LAS unsigned char* lds, int c, int G) {
    const int lane = tid & 63, wave = __builtin_amdgcn_readfirstlane(tid >> 6);
    bf16_t* YOT = (bf16_t*)(p.ws() + WS_YOT); const float* dsk = p.in(I_HYD);
    {
        constexpr int RKS = 8192 + 32, ZS = 78 * 64 + 32; LAS unsigned char* rk = lds; LAS unsigned char* z = lds + 8 * RKS; LAS bf16_t* x0 = (LAS bf16_t*)(z + 4 * ZS);
        HyCh<2048, 4, NTHR> R; if (c < 1024) R.load(p, tid, 4096, c);
        for (int d = c; d < 1024; d += G) {
            R.store(p, tid, d, rk, z, ZS, x0);
            __syncthreads();
            HyCh<2048, 4, NTHR>::copies(tid, rk, RKS);
            __syncthreads();
            if (d + G < 1024) R.load(p, tid, 4096, d + G);
            const int I0 = wave * 8; const f32x16 acc = conv_mfma(rk, RKS, z, ZS, 2048, I0, I0 - 63, I0 + 7, lane);
            hy_epi(acc, z, ZS, x0, 2048, I0, 0, dsk[d], YOT, 4096, d, lane);
            __syncthreads();
        }
    }
    {
        constexpr int RKS = 1024 + 32, ZS = 22 * 64 + 32, CH = 8 * RKS + 16 * ZS + 16 * 256 * 2; const int cs = wave >> 2, w4 = wave & 3, t2 = tid & 255;
        LAS unsigned char* rk = lds + cs * CH; LAS unsigned char* z = rk + 8 * RKS; LAS bf16_t* x0 = (LAS bf16_t*)(z + 16 * ZS);
        HyCh<256, 16, 256> R; if (c < 512) R.load(p, t2, 0, c * 2 + cs);
        for (int dp = c; dp < 512; dp += G) {
            const int d = dp * 2 + cs;
            R.store(p, t2, d, rk, z, ZS, x0);
            __syncthreads();
            HyCh<256, 16, 256>::copies(t2, rk, RKS);
            __syncthreads();
            if (dp + G < 512) R.load(p, t2, 0, (dp + G) * 2 + cs);
            const f32x16 acc = conv_mfma(rk, RKS, z + w4 * 4 * ZS, ZS, 256, 0, -7, 7, lane);
            hy_epi(acc, z, ZS, x0, 256, 0, w4 * 4, dsk[d], YOT, 0, d, lane);
            __syncthreads();
        }
    }
}
__device__ __forceinline__ void hyena_transpose_phase(const KP& p, LAS unsigned char* lds, int gw, int NGW, int lane, int wave) {
    const bf16_t* YOT = (const bf16_t*)(p.ws() + WS_YOT); bf16_t* YO = (bf16_t*)(p.ws() + WS_YO);
    LAS bf16_t* tl = (LAS bf16_t*)(lds + wave * (64 * 66 * 2));
    for (int it = gw; it < 192 * 16; it += NGW) {
        const int tt = it >> 4, dg = it & 15; int start, L, l0; { const int t0 = tt * 64; if (t0 < 4096) { start = t0 & ~255; L = 256; } else { start = 4096 + ((t0 - 4096) & ~2047); L = 2048; } l0 = t0 - start; }
        u32x4 vv[8];
#pragma unroll
        for (int j = 0; j < 8; ++j) { const int ch = j * 8 + (lane >> 3), tq = (lane & 7) * 8; vv[j] = *(const u32x4*)(YOT + (size_t)start * 1024 + (size_t)(dg * 64 + ch) * L + l0 + tq); }
#pragma unroll
        for (int j = 0; j < 8; ++j) { const int ch = j * 8 + (lane >> 3), tq = (lane & 7) * 8;
            const unsigned w[4] = {vv[j].x, vv[j].y, vv[j].z, vv[j].w};
#pragma unroll
            for (int e = 0; e < 4; ++e) { tl[(tq + 2 * e) * 66 + ch] = (bf16_t)(w[e] & 0xffffu); tl[(tq + 2 * e + 1) * 66 + ch] = (bf16_t)(w[e] >> 16); } }
        asm volatile("s_waitcnt lgkmcnt(0)" ::: "memory");
#pragma unroll
        for (int j = 0; j < 8; ++j) { const int t = j * 8 + (lane >> 3), cq = (lane & 7) * 8;
            u32x4 o; const LAS unsigned* src = (const LAS unsigned*)(tl + t * 66 + cq); o.x = src[0]; o.y = src[1]; o.z = src[2]; o.w = src[3];
            *(u32x4*)(YO + (size_t)(start + l0 + t) * 1024 + dg * 64 + cq) = o; }
        asm volatile("s_waitcnt lgkmcnt(0)" ::: "memory");
    }
}

constexpr int TC = 32;
constexpr int SCAN_GRP_LDS = 59904;
struct ScanRaw { u32x2 r, k, v, e, a; };
__device__ __forceinline__ void scan_load(ScanRaw& R, const bf16_t* RKV, const bf16_t* E, const bf16_t* AA, size_t ro) {
    R.r = *(const u32x2*)(RKV + ro); R.k = *(const u32x2*)(RKV + (size_t)T_TOK * 1024 + ro); R.v = *(const u32x2*)(RKV + (size_t)2 * T_TOK * 1024 + ro); R.e = *(const u32x2*)(E + ro); R.a = *(const u32x2*)(AA + ro);
}
__device__ __forceinline__ f32x4 unpk4(u32x2 w) { return (f32x4){bflo(w.x), bfhi(w.x), bflo(w.y), bfhi(w.y)}; }
__device__ __forceinline__ void scan_decode(int q, int& start, int& L, int& b, int& h, int& dir, int& half, bool& sample) {
    sample = q < 256;
    if (sample) { b = q >> 6; h = (q >> 2) & 15; dir = (q >> 1) & 1; half = q & 1; start = 4096 + b * 2048; L = 2048; }
    else { const int r = q - 256; b = r >> 5; h = (r >> 1) & 15; dir = r & 1; half = 0; start = b * 256; L = 256; }
}
__device__ __forceinline__ int scan_item_of(int c, int G, int grp, int i) {
    if (G == 256) { if (grp == 0) return i == 0 ? c : -1; return i < 2 ? 256 + 2 * c + i : -1; }
    const int q = (c * 2 + grp) + i * 2 * G; return q < 768 ? q : -1;
}
__device__ __forceinline__ int scan_slot_chunks(int c, int G, int grp) { int n = 0; for (int i = 0;; ++i) { const int q = scan_item_of(c, G, grp, i); if (q < 0) break; n += (q < 256 ? 2048 : 256) / TC; } return n; }
#define LO2(x) ((f32x2){(x)[0], (x)[1]})
#define HI2(x) ((f32x2){(x)[2], (x)[3]})
struct StepV { f32x4 k0, k1, q0, q1, w0, w1, b0, b1, d0, d1; f32x2 vv, bg; };
template <int NR>
__device__ __forceinline__ void scan_steps(const int dir, const int sk, const int kq, const int row0, LAS float* KKN, LAS float* Qs, LAS float* Ws, LAS float* Bs, LAS float* KDs, LAS float* Vs,
                                           LAS float* OBs, LAS float* BG, LAS float* DUMP, f32x2 (&sA)[4], f32x2 (&sB)[4]) {
#define SCAN_LD(V, st_) do { const int tl_ = dir == 0 ? (st_) : TC - 1 - (st_); const int o_ = tl_ * 64 + sk; \
    V.k0 = *(const LAS f32x4*)(KKN + o_); V.k1 = *(const LAS f32x4*)(KKN + o_ + 4); V.q0 = *(const LAS f32x4*)(Qs + o_); V.q1 = *(const LAS f32x4*)(Qs + o_ + 4); \
    V.w0 = *(const LAS f32x4*)(Ws + o_); V.w1 = *(const LAS f32x4*)(Ws + o_ + 4); V.b0 = *(const LAS f32x4*)(Bs + o_); V.b1 = *(const LAS f32x4*)(Bs + o_ + 4); \
    V.d0 = *(const LAS f32x4*)(KDs + o_); V.d1 = *(const LAS f32x4*)(KDs + o_ + 4); \
    if (NR == 2) V.vv = *(const LAS f32x2*)(Vs + tl_ * 64 + row0); else V.vv = (f32x2){Vs[tl_ * 64 + row0], 0.f}; V.bg = *(const LAS f32x2*)(BG + tl_ * 2); } while (0)
    StepV cur; SCAN_LD(cur, 0);
#pragma unroll 2
    for (int st = 0; st < TC; ++st) {
        const int tl = dir == 0 ? st : TC - 1 - st;
        StepV nxt; { const int sn = st + 1 < TC ? st + 1 : st; SCAN_LD(nxt, sn); }
        const f32x2 a0 = sA[0] * LO2(cur.k0) + sA[1] * HI2(cur.k0) + sA[2] * LO2(cur.k1) + sA[3] * HI2(cur.k1), p0 = sA[0] * LO2(cur.q0) + sA[1] * HI2(cur.q0) + sA[2] * LO2(cur.q1) + sA[3] * HI2(cur.q1);
        float sa0 = a0[0] + a0[1], pp0 = p0[0] + p0[1], sa1 = 0.f, pp1 = 0.f;
        if (NR == 2) { const f32x2 a1 = sB[0] * LO2(cur.k0) + sB[1] * HI2(cur.k0) + sB[2] * LO2(cur.k1) + sB[3] * HI2(cur.k1), p1 = sB[0] * LO2(cur.q0) + sB[1] * HI2(cur.q0) + sB[2] * LO2(cur.q1) + sB[3] * HI2(cur.q1);
            sa1 = a1[0] + a1[1]; pp1 = p1[0] + p1[1]; }
        if (NR == 2) {
#define SCAN_RED(NOP, CTRL) asm volatile(NOP "v_add_f32_dpp %0, %0, %0 " CTRL " row_mask:0xf bank_mask:0xf bound_ctrl:1\n\tv_add_f32_dpp %1, %1, %1 " CTRL " row_mask:0xf bank_mask:0xf bound_ctrl:1\n\t" \
                               "v_add_f32_dpp %2, %2, %2 " CTRL " row_mask:0xf bank_mask:0xf bound_ctrl:1\n\tv_add_f32_dpp %3, %3, %3 " CTRL " row_mask:0xf bank_mask:0xf bound_ctrl:1" : "+v"(sa0), "+v"(pp0), "+v"(sa1), "+v"(pp1))
            SCAN_RED("s_nop 1\n\t", "quad_perm:[1,0,3,2]"); SCAN_RED("", "quad_perm:[2,3,0,1]"); SCAN_RED("", "row_half_mirror");
#undef SCAN_RED
        } else {
#define SCAN_RED1(CTRL) asm volatile("s_nop 1\n\tv_add_f32_dpp %0, %0, %0 " CTRL " row_mask:0xf bank_mask:0xf bound_ctrl:1\n\tv_add_f32_dpp %1, %1, %1 " CTRL " row_mask:0xf bank_mask:0xf bound_ctrl:1" : "+v"(sa0), "+v"(pp0))
            SCAN_RED1("quad_perm:[1,0,3,2]"); SCAN_RED1("quad_perm:[2,3,0,1]"); SCAN_RED1("row_half_mirror");
#undef SCAN_RED1
        }
        const f32x2 sv0 = {sa0, sa0}, vv0 = {cur.vv[0], cur.vv[0]};
        sA[0] = sA[0] * LO2(cur.w0) + sv0 * LO2(cur.b0) + vv0 * LO2(cur.d0); sA[1] = sA[1] * HI2(cur.w0) + sv0 * HI2(cur.b0) + vv0 * HI2(cur.d0);
        sA[2] = sA[2] * LO2(cur.w1) + sv0 * LO2(cur.b1) + vv0 * LO2(cur.d1); sA[3] = sA[3] * HI2(cur.w1) + sv0 * HI2(cur.b1) + vv0 * HI2(cur.d1);
        if (NR == 2) { const f32x2 sv1 = {sa1, sa1}, vv1 = {cur.vv[1], cur.vv[1]};
            sB[0] = sB[0] * LO2(cur.w0) + sv1 * LO2(cur.b0) + vv1 * LO2(cur.d0); sB[1] = sB[1] * HI2(cur.w0) + sv1 * HI2(cur.b0) + vv1 * HI2(cur.d0);
            sB[2] = sB[2] * LO2(cur.w1) + sv1 * LO2(cur.b1) + vv1 * LO2(cur.d1); sB[3] = sB[3] * HI2(cur.w1) + sv1 * HI2(cur.b1) + vv1 * HI2(cur.d1);
            *(LAS f32x2*)(kq == 0 ? OBs + tl * 64 + row0 : DUMP) = (f32x2){pp0 + sa0 * cur.bg[0] + cur.vv[0] * cur.bg[1], pp1 + sa1 * cur.bg[0] + cur.vv[1] * cur.bg[1]}; }
        else *(kq == 0 ? OBs + tl * 64 + row0 : DUMP) = pp0 + sa0 * cur.bg[0] + cur.vv[0] * cur.bg[1];
        cur = nxt;
    }
#undef SCAN_LD
}
__device__ __forceinline__ void scan_prep_row(const ScanRaw& R, const int ptl, const int pkq, const int ppk, const f32x4 kkw, const f32x4 kaw, const f32x4 rkw, float* rho_dst, LAS float* base) {
    LAS float* KKN = base; LAS float* Qs = KKN + TC * 64; LAS float* Ws = Qs + TC * 64; LAS float* Bs = Ws + TC * 64; LAS float* KDs = Bs + TC * 64; LAS float* Vs = KDs + TC * 64; LAS float* BG = Vs + 2 * TC * 64;
    const f32x4 r4 = unpk4(R.r), k4 = unpk4(R.k), v4 = unpk4(R.v), e4 = unpk4(R.e), a4 = unpk4(R.a);
    f32x4 kk = k4 * kkw; float n2 = (kk[0] * kk[0] + kk[1] * kk[1]) + (kk[2] * kk[2] + kk[3] * kk[3]);
    n2 = sum16(n2);
    const float inv = 1.f / fmaxf(sqrtf(n2), 1e-12f); kk = kk * inv;
    f32x4 w;
#pragma unroll
    for (int e = 0; e < 4; ++e) w[e] = __expf(-e4[e]);
    const f32x4 kd = k4 * (1.f + (a4 - 1.f) * kaw), bb = kk * a4, q = w * r4;
    float be = (bb[0] * r4[0] + bb[1] * r4[1]) + (bb[2] * r4[2] + bb[3] * r4[3]), ga = (kd[0] * r4[0] + kd[1] * r4[1]) + (kd[2] * r4[2] + kd[3] * r4[3]);
    be = sum16(be); ga = sum16(ga);
    float rho = (r4[0] * kd[0] * rkw[0] + r4[1] * kd[1] * rkw[1]) + (r4[2] * kd[2] * rkw[2] + r4[3] * kd[3] * rkw[3]); rho = sum16(rho);
    if (pkq == 0 && rho_dst) *rho_dst = rho;
    const int o = ptl * 64 + ppk;
    *(LAS f32x4*)(KKN + o) = -kk; *(LAS f32x4*)(Qs + o) = q; *(LAS f32x4*)(Ws + o) = w; *(LAS f32x4*)(Bs + o) = bb; *(LAS f32x4*)(KDs + o) = kd; *(LAS f32x4*)(Vs + o) = v4;
    if (pkq == 0) { BG[ptl * 2] = be; BG[ptl * 2 + 1] = ga; }
}
__device__ __forceinline__ void scan_phase(const KP& p, const int tid, LAS unsigned char* lds_all, int c, int G) {
    const int grp = __builtin_amdgcn_readfirstlane(tid >> 8), t = tid & 255;
    const bf16_t* RKV = (const bf16_t*)(p.ws() + WS_RKV); float* RHO = (float*)(p.ws() + WS_L1);
    const int n0 = scan_slot_chunks(c, G, 0), n1 = scan_slot_chunks(c, G, 1), nslots = n0 > n1 ? n0 : n1;
    const bool hok = (G == 256) && (n1 & 1) == 0;
    const int prp = t >> 4, pkq = t & 15, ppk = pkq * 4;
    const int rp = t >> 3, kq = t & 7, sk = kq * 8;
    int item = -1, ch = 0, nch = 0, start = 0, L = 0, b = 0, h = 0, dir = 0, half = 0, row0 = 0; bool sample = false, done = false;
    const bf16_t* E = nullptr; const bf16_t* AA = nullptr; bf16_t* O = nullptr; int col = 0;
    f32x4 kkw = {0.f, 0.f, 0.f, 0.f}, kaw = {0.f, 0.f, 0.f, 0.f}, rkw = {0.f, 0.f, 0.f, 0.f};
    f32x2 sA[4], sB[4];
#pragma unroll
    for (int e = 0; e < 4; ++e) { sA[e] = (f32x2){0.f, 0.f}; sB[e] = (f32x2){0.f, 0.f}; }
    ScanRaw R0, R1;
    for (int gc = 0; gc < nslots; ++gc) {
        const bool asst = hok && gc >= n1 + 1;
        const bool helper = hok && grp == 1 && gc >= n1;
        if (helper && gc == n1) {
            scan_decode(scan_item_of(c, G, 0, 0), start, L, b, h, dir, half, sample); col = h * 64 + ppk;
            E = (const bf16_t*)(p.ws() + WS_E) + (size_t)dir * T_TOK * 1024; AA = (const bf16_t*)(p.ws() + WS_AA) + (size_t)dir * T_TOK * 1024; O = (bf16_t*)(p.ws() + (dir == 0 ? WS_OF : WS_OB));
            kkw = *(const f32x4*)(p.in(I_KK) + col); kaw = *(const f32x4*)(p.in(I_KA) + col); rkw = *(const f32x4*)(p.in(I_RK) + col); done = true; }
        if (!helper && !done && ch == nch) {
            ++item; const int q = scan_item_of(c, G, grp, item);
            if (q < 0) done = true;
            else { scan_decode(q, start, L, b, h, dir, half, sample); nch = L / TC; ch = 0; col = h * 64 + ppk; row0 = sample ? half * 32 + rp : 2 * rp;
                E = (const bf16_t*)(p.ws() + WS_E) + (size_t)dir * T_TOK * 1024; AA = (const bf16_t*)(p.ws() + WS_AA) + (size_t)dir * T_TOK * 1024; O = (bf16_t*)(p.ws() + (dir == 0 ? WS_OF : WS_OB));
                kkw = *(const f32x4*)(p.in(I_KK) + col); kaw = *(const f32x4*)(p.in(I_KA) + col); rkw = *(const f32x4*)(p.in(I_RK) + col);
#pragma unroll
                for (int e = 0; e < 4; ++e) { sA[e] = (f32x2){0.f, 0.f}; sB[e] = (f32x2){0.f, 0.f}; }
                if (sample) { const float* st = p.in(dir == 0 ? I_SF : I_SB) + (((size_t)b * 16 + h) * 64 + row0) * 64 + sk; const f32x4 a0 = *(const f32x4*)st, a1 = *(const f32x4*)(st + 4);
                    sA[0] = (f32x2){a0[0], a0[1]}; sA[1] = (f32x2){a0[2], a0[3]}; sA[2] = (f32x2){a1[0], a1[1]}; sA[3] = (f32x2){a1[2], a1[3]}; }
                const int tb0 = dir == 0 ? 0 : L - TC;
                scan_load(R0, RKV, E, AA, (size_t)(start + tb0 + prp) * 1024 + col); scan_load(R1, RKV, E, AA, (size_t)(start + tb0 + prp + 16) * 1024 + col); }
        }
        const bool active = !done && !helper; const int tbase = dir == 0 ? ch * TC : L - (ch + 1) * TC;
        LAS float* base = (LAS float*)(lds_all + ((grp == 0 && asst) ? (gc & 1) : grp) * SCAN_GRP_LDS);
        LAS float* KKN = base; LAS float* Qs = KKN + TC * 64; LAS float* Ws = Qs + TC * 64; LAS float* Bs = Ws + TC * 64; LAS float* KDs = Bs + TC * 64; LAS float* Vs = KDs + TC * 64;
        LAS float* OBs = Vs + TC * 64; LAS float* BG = OBs + TC * 64;
        LAS float* DUMP = (LAS float*)(lds_all + grp * SCAN_GRP_LDS) + 7 * TC * 64 + TC * 2 + t * 2;
        if (active && !(grp == 0 && asst)) {
            scan_prep_row(R0, prp, pkq, ppk, kkw, kaw, rkw, half == 0 ? RHO + ((size_t)dir * T_TOK + start + tbase + prp) * 16 + h : nullptr, base);
            scan_prep_row(R1, prp + 16, pkq, ppk, kkw, kaw, rkw, half == 0 ? RHO + ((size_t)dir * T_TOK + start + tbase + prp + 16) * 16 + h : nullptr, base);
        }
        if (helper) {
            const int kn = gc + 1; const bool do_prep = kn < nslots; ScanRaw H0, H1;
            const int tbn = dir == 0 ? kn * TC : L - (kn + 1) * TC;
            if (do_prep) { scan_load(H0, RKV, E, AA, (size_t)(start + tbn + prp) * 1024 + col); scan_load(H1, RKV, E, AA, (size_t)(start + tbn + prp + 16) * 1024 + col); }
            if (gc >= n1 + 2) { const int kp = gc - 1; const int tbp = dir == 0 ? kp * TC : L - (kp + 1) * TC; LAS float* ob = (LAS float*)(lds_all + (kp & 1) * SCAN_GRP_LDS) + 6 * TC * 64;
                const int otl = t >> 3, oc = half * 32 + (t & 7) * 4; const f32x4 o0 = *(const LAS f32x4*)(ob + otl * 64 + oc);
                u32x2 w; w.x = cvt_pk_bf16(o0[0], o0[1]); w.y = cvt_pk_bf16(o0[2], o0[3]); *(u32x2*)(O + (size_t)(start + tbp + otl) * 1024 + h * 64 + oc) = w; }
            if (do_prep) { LAS float* nb = (LAS float*)(lds_all + (kn & 1) * SCAN_GRP_LDS);
                scan_prep_row(H0, prp, pkq, ppk, kkw, kaw, rkw, half == 0 ? RHO + ((size_t)dir * T_TOK + start + tbn + prp) * 16 + h : nullptr, nb);
                scan_prep_row(H1, prp + 16, pkq, ppk, kkw, kaw, rkw, half == 0 ? RHO + ((size_t)dir * T_TOK + start + tbn + prp + 16) * 16 + h : nullptr, nb); }
        }
        if (!asst) __syncthreads();
        if (active) {
            if (ch + 1 < nch && !(grp == 0 && hok && gc + 1 >= n1 + 1)) { const int tb2 = dir == 0 ? (ch + 1) * TC : L - (ch + 2) * TC;
                scan_load(R0, RKV, E, AA, (size_t)(start + tb2 + prp) * 1024 + col); scan_load(R1, RKV, E, AA, (size_t)(start + tb2 + prp + 16) * 1024 + col); }
            if (sample) scan_steps<1>(dir, sk, kq, row0, KKN, Qs, Ws, Bs, KDs, Vs, OBs, BG, DUMP, sA, sB);
            else scan_steps<2>(dir, sk, kq, row0, KKN, Qs, Ws, Bs, KDs, Vs, OBs, BG, DUMP, sA, sB);
        }
        __syncthreads();
        if (active) {
            if (sample) { if (!(asst && gc + 1 < nslots)) { const int otl = t >> 3, oc = half * 32 + (t & 7) * 4; const f32x4 o0 = *(const LAS f32x4*)(OBs + otl * 64 + oc);
                u32x2 w; w.x = cvt_pk_bf16(o0[0], o0[1]); w.y = cvt_pk_bf16(o0[2], o0[3]); *(u32x2*)(O + (size_t)(start + tbase + otl) * 1024 + h * 64 + oc) = w; } }
            else { const int otl = t >> 3, oc = (t & 7) * 8; const f32x4 o0 = *(const LAS f32x4*)(OBs + otl * 64 + oc), o1 = *(const LAS f32x4*)(OBs + otl * 64 + oc + 4);
                u32x4 w; w.x = cvt_pk_bf16(o0[0], o0[1]); w.y = cvt_pk_bf16(o0[2], o0[3]); w.z = cvt_pk_bf16(o1[0], o1[1]); w.w = cvt_pk_bf16(o1[2], o1[3]);
                *(u32x4*)(O + (size_t)(start + tbase + otl) * 1024 + h * 64 + oc) = w; }
            ++ch;
            if (ch == nch && !sample) { float* so = p.out() + (size_t)T_TOK * 1024 + (size_t)dir * 1048576 + (((size_t)b * 16 + h) * 64 + row0) * 64 + sk;
                *(f32x4*)so = (f32x4){sA[0][0], sA[0][1], sA[1][0], sA[1][1]}; *(f32x4*)(so + 4) = (f32x4){sA[2][0], sA[2][1], sA[3][0], sA[3][1]};
                *(f32x4*)(so + 64) = (f32x4){sB[0][0], sB[0][1], sB[1][0], sB[1][1]}; *(f32x4*)(so + 68) = (f32x4){sB[2][0], sB[2][1], sB[3][0], sB[3][1]}; }
        }
    }
    __syncthreads();
}
#undef LO2
#undef HI2
__device__ __forceinline__ float sum32(float v) { v = sum16(v); return v + __builtin_bit_cast(float, __builtin_amdgcn_ds_swizzle(__builtin_bit_cast(int, v), 0x401F)); }
__device__ __forceinline__ void rwkv_post_phase(const KP& p, int gw, int NGW, int lane) {
    const bf16_t* RKV = (const bf16_t*)(p.ws() + WS_RKV); const bf16_t* Gb = (const bf16_t*)(p.ws() + WS_G);
    bf16_t* OF = (bf16_t*)(p.ws() + WS_OF); const bf16_t* OB = (const bf16_t*)(p.ws() + WS_OB); const float* RHO = (const float*)(p.ws() + WS_L1);
    const size_t TS = (size_t)T_TOK * 1024; const int hl = lane >> 5, l2 = (lane & 31) * 2;
    for (int pr0 = gw * 8; pr0 < T_TOK * 8; pr0 += NGW * 8) {
        unsigned wf[8], wb[8], wv[8], wg[8]; float r0[8], r1[8]; int hh[8]; size_t oo[8];
#pragma unroll
        for (int q = 0; q < 8; ++q) { const int pr = pr0 + q, row = pr >> 3, h = (pr & 7) * 2 + hl; const size_t o = (size_t)row * 1024 + h * 64 + l2; hh[q] = h; oo[q] = o;
            wf[q] = *(const unsigned*)(OF + o); wb[q] = *(const unsigned*)(OB + o); wv[q] = *(const unsigned*)(RKV + 2 * TS + o); wg[q] = *(const unsigned*)(Gb + o);
            r0[q] = RHO[(size_t)row * 16 + h]; r1[q] = RHO[((size_t)T_TOK + row) * 16 + h]; }
#pragma unroll
        for (int q = 0; q < 8; ++q) { const int cc = hh[q] * 64 + l2;
            const float o0 = bflo(wf[q]) + bflo(wb[q]), o1 = bfhi(wf[q]) + bfhi(wb[q]);
            const float mu = sum32(o0 + o1) * (1.f / 64.f), d0 = o0 - mu, d1 = o1 - mu; const float var = sum32(d0 * d0 + d1 * d1) * (1.f / 64.f), rs = rsqrtf(var + 64e-5f);
            const f32x2 lw = *(const f32x2*)(p.in(I_LNW) + cc), lb = *(const f32x2*)(p.in(I_LNB) + cc);
            const float rho = r0[q] + r1[q];
            const float on0 = d0 * rs * lw[0] + lb[0] + rho * bflo(wv[q]), on1 = d1 * rs * lw[1] + lb[1] + rho * bfhi(wv[q]);
            *(unsigned*)(OF + oo[q]) = cvt_pk_bf16(on0 * bflo(wg[q]), on1 * bfhi(wg[q])); }
    }
}

__device__ __forceinline__ void mix_phase(const KP& p, int gw, int NGW, int lane) {
    const bf16_t* H = (const bf16_t*)(p.ws() + WS_H); bf16_t* XM = (bf16_t*)(p.ws() + WS_XM); const float* mix = p.in(I_MIX);
    for (int it = gw; it < (T_TOK / 2) * 4; it += NGW) {
        const int j = it & 3, r = (it >> 2) * 2, cc = 4 * lane + 256 * j; int s0, s1; if (r < 4096) { s0 = r & ~255; s1 = s0 + 256; } else { s0 = 4096 + ((r - 4096) & ~2047); s1 = s0 + 2048; }
        const size_t o = (size_t)r * 1024 + cc;
        const u32x2 w0 = *(const u32x2*)(H + (r > s0 ? o - 1024 : o)), w1 = *(const u32x2*)(H + o), w2 = *(const u32x2*)(H + o + 1024), w3 = *(const u32x2*)(H + (r + 2 < s1 ? o + 2048 : o));
        f32x4 mx[6];
#pragma unroll
        for (int m = 0; m < 6; ++m) mx[m] = *(const f32x4*)(mix + m * 1024 + cc);
        const float k0 = r > s0 ? 1.f : 0.f, k3 = r + 2 < s1 ? 1.f : 0.f;
        const f32x4 h0 = unpk4(w0) * k0, h1 = unpk4(w1), h2 = unpk4(w2), h3 = unpk4(w3) * k3;
        const f32x4 xa = 0.5f * (h0 + h2) - h1, xb = 0.5f * (h1 + h3) - h2;
#pragma unroll
        for (int m = 0; m < 6; ++m) { const int slot = m == 0 ? 0 : (m == 1 ? 3 : (m == 2 ? 1 : (m == 3 ? 2 : m))); const f32x4 va = h1 + xa * mx[m], vb = h2 + xb * mx[m];
            u32x2 wa, wb; wa.x = cvt_pk_bf16(va[0], va[1]); wa.y = cvt_pk_bf16(va[2], va[3]); wb.x = cvt_pk_bf16(vb[0], vb[1]); wb.y = cvt_pk_bf16(vb[2], vb[3]);
            *(u32x2*)(XM + (size_t)slot * T_TOK * 1024 + o) = wa; *(u32x2*)(XM + (size_t)slot * T_TOK * 1024 + o + 1024) = wb; }
    }
}

#define XB_TMO      128
#define XB_XCNT(j)  (256  + 64 * (j))
#define XB_XSUB(j)  (1280 + 64 * (j))
#define XB_XGEN(j)  (2304 + 64 * (j))
#define XB_TOP      3328
#define XB_TOPGEN   3392
#define XCD_BAR_WORDS 3456
#define XB_SPIN_CAP (1u << 18)

__device__ __forceinline__ unsigned xb_ld(unsigned* p)              { return __hip_atomic_load(p, __ATOMIC_RELAXED, __HIP_MEMORY_SCOPE_AGENT); }
__device__ __forceinline__ unsigned xb_add(unsigned* p, unsigned v) { return __hip_atomic_fetch_add(p, v, __ATOMIC_RELAXED, __HIP_MEMORY_SCOPE_AGENT); }
__device__ __forceinline__ unsigned xb_xcc_id() { return (unsigned)__builtin_amdgcn_s_getreg((3 << 11) | 20) & 0xFu; }
#define XB_SPIN(cond, bar) do { unsigned _sp = 0; while (cond) { __builtin_amdgcn_s_sleep(1); \
    if ((++_sp & 255u) == 0u) { if (xb_ld(&(bar)[XB_TMO])) break; if (_sp > XB_SPIN_CAP) { xb_add(&(bar)[XB_TMO], 1u); break; } } } } while (0)

struct XcdBarrier {
    unsigned* bar; unsigned x;
    volatile LAS unsigned* st;
};

__device__ __forceinline__ XcdBarrier xcd_barrier_post(unsigned* bar, volatile LAS unsigned* st) {
    XcdBarrier b; b.bar = bar; b.x = xb_xcc_id(); b.st = st;
    if (threadIdx.x == 0) (void)xb_add(&bar[XB_XCNT(b.x)], 1u);
    return b;
}
__device__ __forceinline__ void xcd_barrier_complete(unsigned* bar, unsigned x, unsigned& nloc, unsigned& nx) {
    const unsigned G = gridDim.x * gridDim.y * gridDim.z;
    unsigned sum, cnt, mine, sp = 0u;
    for (;;) {
        sum = 0u; cnt = 0u; mine = 0u;
#pragma unroll
        for (unsigned j = 0; j < 16; ++j) { const unsigned c = xb_ld(&bar[XB_XCNT(j)]); sum += c; cnt += (c > 0u) ? 1u : 0u; mine = (j == x) ? c : mine; }
        if (sum == G) break;
        __builtin_amdgcn_s_sleep(1);
        if ((++sp & 255u) == 0u) { if (xb_ld(&bar[XB_TMO])) break; if (sp > XB_SPIN_CAP) { xb_add(&bar[XB_TMO], 1u); break; } }
    }
    nloc = mine > 0u ? mine : 1u; nx = cnt > 0u ? cnt : 1u;
}

__device__ __forceinline__ void xcd_barrier(const XcdBarrier& b) {
    asm volatile("s_waitcnt vmcnt(0)" ::: "memory");
    __syncthreads();
    if (threadIdx.x == 0) {
        unsigned* bar = b.bar;
        __builtin_amdgcn_s_waitcnt(0);
        unsigned nloc = b.st[0], nx = b.st[1];
        if (nloc == 0u) { xcd_barrier_complete(bar, b.x, nloc, nx); b.st[0] = nloc; b.st[1] = nx; }
        const unsigned old = xb_add(&bar[XB_XSUB(b.x)], 1u);
        const unsigned gen = old / nloc;
        if (old + 1u == (gen + 1u) * nloc) {
            __builtin_amdgcn_fence(__ATOMIC_RELEASE, "agent");
            asm volatile("s_waitcnt vmcnt(0)" ::: "memory");
            const unsigned og = xb_add(&bar[XB_TOP], 1u);
            const unsigned tg = og / nx;
            if (og + 1u == (tg + 1u) * nx) xb_add(&bar[XB_TOPGEN], 1u);
            else XB_SPIN(xb_ld(&bar[XB_TOPGEN]) == tg, bar);
            __builtin_amdgcn_fence(__ATOMIC_ACQUIRE, "agent");
            xb_add(&bar[XB_XGEN(b.x)], 1u);
            asm volatile("s_waitcnt vmcnt(0)" ::: "memory");
        } else {
            XB_SPIN(xb_ld(&bar[XB_XGEN(b.x)]) == gen, bar);
            __builtin_amdgcn_fence(__ATOMIC_ACQUIRE, "agent");
            asm volatile("s_waitcnt vmcnt(0)" ::: "memory");
        }
    }
    __syncthreads();
}

#define PE(code, l, nosync) (unsigned char)((code) | ((l) << 5) | ((nosync) << 7))
__device__ const unsigned char PROG[36] = {
    PE(PH_PREP, 0, 0), PE(PH_R0, 0, 0),
    PE(PH_FG1, 0, 0), PE(PH_FG2S, 0, 1), PE(PH_FG2P, 0, 0), PE(PH_FG3, 0, 0), PE(PH_RMID, 0, 0), PE(PH_NG1, 0, 0), PE(PH_NG2, 0, 0), PE(PH_REND, 0, 0),
    PE(PH_HG1, 1, 0), PE(PH_HC, 1, 0), PE(PH_HT, 1, 0), PE(PH_HG2, 1, 0), PE(PH_RMID, 1, 0), PE(PH_NG1, 1, 0), PE(PH_NG2, 1, 0), PE(PH_REND, 1, 0), PE(PH_MIX, 1, 0),
    PE(PH_RG1, 2, 0), PE(PH_RG2, 2, 0), PE(PH_RS, 2, 0), PE(PH_RP, 2, 0), PE(PH_RG3, 2, 0), PE(PH_RMID, 2, 0), PE(PH_NG1, 2, 0), PE(PH_NG2, 2, 0), PE(PH_REND, 2, 0),
    PE(PH_FG1, 3, 0), PE(PH_FG2S, 3, 1), PE(PH_FG2P, 3, 0), PE(PH_FG3, 3, 0), PE(PH_RMID, 3, 0), PE(PH_NG1, 3, 0), PE(PH_NG2, 3, 0), PE(PH_REND, 3, 1) };

__global__ void __launch_bounds__(NTHR) mega_fwd(Params pp) {
    extern __shared__ __attribute__((aligned(16))) unsigned char lds_raw[];
    volatile LAS unsigned* xst = (volatile LAS unsigned*)((LAS unsigned char*)lds_raw + 160000);
    if (threadIdx.x < 2) xst[threadIdx.x] = 0u;
    __syncthreads();
    unsigned* xbar_words; { const KP p0{(kin_t)__builtin_amdgcn_kernarg_segment_ptr()}; xbar_words = (unsigned*)(p0.ws() + WS_CTL); }
    XcdBarrier xbar; xbar.bar = xbar_words; xbar.x = xb_xcc_id(); xbar.st = xst;
    if (blockIdx.x == 0) { for (int i = threadIdx.x; i < (int)(CTL_BYTES / 16); i += NTHR) ((u32x4*)xbar_words)[i] = (u32x4){0u, 0u, 0u, 0u}; }
#ifndef PROBE_CLASS
#define PROBE_CLASS 0
#endif
    unsigned long long tacc = 0ull;
#pragma unroll 1
    for (int ph = 0; ph < 36; ++ph) {
        unsigned long long kv = (unsigned long long)__builtin_amdgcn_kernarg_segment_ptr(); asm volatile("" : "+s"(kv));
        int tid = threadIdx.x; asm volatile("" : "+v"(tid));
        int G = gridDim.x, bx = blockIdx.x; asm volatile("" : "+s"(G), "+s"(bx));
        unsigned ldsv = (unsigned)(size_t)(LAS unsigned char*)lds_raw; asm volatile("" : "+s"(ldsv));
        LAS unsigned char* lds = (LAS unsigned char*)(size_t)ldsv;
        const int lane = tid & 63, wave = __builtin_amdgcn_readfirstlane(tid >> 6);
        const int c = (G % 8 == 0) ? (bx % 8) * (G / 8) + bx / 8 : bx;
        const int gw = c * NWAVES + wave, NGW = G * NWAVES, gtid = c * NTHR + tid, NT = G * NTHR;
        LAS float* scr = (LAS float*)(lds + wave * 8448);
        const KP p{(kin_t)kv}; unsigned char* ws = p.ws(); const float* MOD = (const float*)(ws + WS_MOD);
        const unsigned pe = PROG[ph]; const int code = pe & 31, l = (pe >> 5) & 3; const bool nosync = (pe >> 7) != 0;
        unsigned long long tp0 = 0ull; if (PROBE_CLASS) tp0 = __builtin_amdgcn_s_memrealtime();
        const bool fuse = (G == 256);
        if (fuse && (code == PH_RMID || code == PH_REND)) continue;
        if (code == PH_MIX) { if (!fuse) continue; mix_phase(p, gw, NGW, lane); }
        else if (code >= 8) {
            int lda = 1024, ldb = 1024, nt = 16;
            if (code == PH_FG1) { lda = 256; nt = 4; } else if (code == PH_FG2S) { lda = 4096; ldb = 4096; nt = 64; } else if (code == PH_FG2P) { lda = 512; ldb = 512; nt = 8; }
            else if (code == PH_RG2) { lda = 384; ldb = 256; nt = 4; } else if (code == PH_NG2) { lda = FF; ldb = FF; nt = 44; }
            if (G > 192 && c >= 192 && (code == PH_FG3 || code == PH_HG2 || code == PH_RG3)) convert_ffn(p, l, scr, (c - 192) * NWAVES + wave, (G - 192) * NWAVES, lane);
            if (G > 192 && c >= 192 && code == PH_FG2S && l == 0) p0_hyfilter(p, tid, (LAS float*)lds, c - 192, G - 192);
            SchedAny S{code, l, G, c, ws, fuse}; const EpiGen E{code, l, c, p};
            gemm_phase<true>(tid, lds, lda, ldb, nt, S, E);
        } else if (code == PH_PREP) {
            if (G == 256) {
                if (c < 96) p0_mod(p, tid, (LAS float*)lds, c, 96);
                else { p0_transposes(p, scr, (c - 96) * NWAVES + wave, 160 * NWAVES, lane); p0_tables(p, (c - 96) * NTHR + tid, 160 * NTHR); }
            } else {
            p0_transposes(p, scr, gw, NGW, lane);
            p0_tables(p, gtid, NT);
            __syncthreads();
            p0_mod(p, tid, (LAS float*)lds, c, G);
            }
            if (G <= 192) p0_hyfilter(p, tid, (LAS float*)lds, c, G);
        } else if (code == PH_HC) {
            hyena_conv_phase(p, tid, lds, c, G);
        } else if (code == PH_HT) {
            hyena_transpose_phase(p, lds, gw, NGW, lane, wave);
        } else if (code == PH_RS) {
            scan_phase(p, tid, lds, c, G);
        } else if (code == PH_RP) {
            rwkv_post_phase(p, gw, NGW, lane);
        } else {
            const float* modl = MOD + (size_t)l * 5 * 6144; const float* ngl = p.in(I_NG) + (size_t)l * 4 * 1024;
            RowCfg cf; cf.h = (bf16_t*)(ws + WS_H); cf.mix = p.in(I_MIX); cf.xm = (bf16_t*)(ws + WS_XM); cf.y = (const bf16_t*)(ws + WS_Y);
            cf.xs_p = (const float*)(ws + WS_X); cf.xs_s = (const float*)(ws + WS_X) + (size_t)4096 * 1024; cf.xdst = (float*)(ws + WS_X);
            bool rw = false;
            if (code == PH_R0) { cf.xs_p = p.in(I_XP); cf.xs_s = p.in(I_XS); cf.xdst = nullptr; cf.y = nullptr; cf.gate = nullptr; cf.ng_post = nullptr; cf.ng_pre = ngl; cf.sc = modl + 1024; cf.sh = modl; }
            else if (code == PH_RMID) {
                if (G <= 192) convert_ffn(p, l, scr, gw, NGW, lane);
                if (l == 0) { cf.xs_p = p.in(I_XP); cf.xs_s = p.in(I_XS); }
                if (l == 2) { cf.xs_p = p.out(); cf.xs_s = p.out() + (size_t)4096 * 1024; }
                cf.gate = modl + 2048; cf.ng_post = ngl + 1024; cf.ng_pre = ngl + 2048; cf.sc = modl + 4096; cf.sh = modl + 3072;
            } else {
                cf.gate = modl + 5120; cf.ng_post = ngl + 3072;
                if (l == 3) { cf.xdst = p.out(); cf.ng_pre = nullptr; cf.sc = nullptr; cf.sh = nullptr; }
                else { cf.ng_pre = ngl + 4096; cf.sc = modl + 5 * 6144 + 1024; cf.sh = modl + 5 * 6144; rw = ((l + 1) % 3 == 2); if (rw) cf.xdst = p.out(); }
            }
            if (rw) row_phase<true>(cf, gw, NGW, lane); else row_phase<false>(cf, gw, NGW, lane);
        }
        if (PROBE_CLASS) {
            const int cls = (code == PH_PREP) ? 2 : (code == PH_R0 || code == PH_RMID || code == PH_REND) ? 3 : (code == PH_NG1 || code == PH_NG2) ? 4 : (code >= 8) ? 5 : (code == PH_HC || code == PH_HT) ? 6 : (code == PH_RS) ? 7 : 8;
            __syncthreads(); const unsigned long long tp1 = __builtin_amdgcn_s_memrealtime();
            if (cls == PROBE_CLASS) tacc += tp1 - tp0;
            if (!nosync) { if (ph == 0) { cg::this_grid().sync(); if (threadIdx.x == 0) (void)xb_add(&xbar.bar[XB_XCNT(xbar.x)], 1u); } else xcd_barrier(xbar); }
            if (PROBE_CLASS == 1) tacc += __builtin_amdgcn_s_memrealtime() - tp1;
        } else {
        if (!nosync) { if (ph == 0) { cg::this_grid().sync(); if (threadIdx.x == 0) (void)xb_add(&xbar.bar[XB_XCNT(xbar.x)], 1u); } else xcd_barrier(xbar); }
        }
    }
    if (PROBE_CLASS) { if (blockIdx.x == 0 && threadIdx.x == 0) { float* o = (float*)((const float* const __attribute__((address_space(4)))*)__builtin_amdgcn_kernarg_segment_ptr())[45]; o[(size_t)T_TOK * 1024] += (float)tacc * 1e-4f; } }
}

extern "C" void kernel_launch(void* const* d_in, const int* in_sizes, int n_in, void* d_out, int out_size, void* d_ws, size_t ws_size, hipStream_t stream) {
    static int grid = 0;
    if (grid == 0) {
        if (n_in != 45 || ws_size < WS_END) { fprintf(stderr, "kernel_launch: need 45 inputs and %zu bytes of workspace; got %d, %zu\n", (size_t)WS_END, n_in, ws_size); grid = -1; return; }
        int dev = 0, cus = 0, per_cu = 0;
        hipGetDevice(&dev); hipDeviceGetAttribute(&cus, hipDeviceAttributeMultiprocessorCount, dev);
        if (hipFuncSetAttribute((const void*)mega_fwd, hipFuncAttributeMaxDynamicSharedMemorySize, LDS_BYTES) != hipSuccess) { fprintf(stderr, "kernel_launch: hipFuncSetAttribute failed\n"); grid = -1; return; }
        if (hipOccupancyMaxActiveBlocksPerMultiprocessor(&per_cu, (const void*)mega_fwd, NTHR, LDS_BYTES) != hipSuccess || per_cu < 1) { fprintf(stderr, "kernel_launch: occupancy query failed (%d)\n", per_cu); (void)hipGetLastError(); per_cu = 1; }
        grid = cus * 1;
    }
    if (grid < 0) return;
    Params a{};
    for (int i = 0; i < 45; ++i) a.in[i] = (const float*)d_in[i];
    a.out = (float*)d_out; a.ws = (unsigned char*)d_ws;
    void* args[] = {&a};
    hipError_t e = hipLaunchCooperativeKernel((const void*)mega_fwd, dim3(grid), dim3(NTHR), args, LDS_BYTES, stream);
    if (e != hipSuccess) fprintf(stderr, "cooperative launch failed: %s (grid %d)\n", hipGetErrorString(e), grid);
}
```

```cpp
#include <hip/hip_runtime.h>
#include <hip/hip_cooperative_groups.h>
#include <cstdio>
#include <cstdint>
namespace cg = cooperative_groups;

#define LAS __attribute__((address_space(3)))
typedef unsigned short bf16_t;
typedef short bf16x8 __attribute__((ext_vector_type(8)));
typedef float f32x4 __attribute__((ext_vector_type(4)));
typedef float f32x2 __attribute__((ext_vector_type(2)));
typedef unsigned u32x4 __attribute__((ext_vector_type(4)));
typedef unsigned u32x2 __attribute__((ext_vector_type(2)));

constexpr int T_TOK = 12288, DM = 1024, FF = 2816;
constexpr int NTHR = 512, NWAVES = 8;
constexpr int LDS_BYTES = 163840;

constexpr size_t SZ_TD2 = (size_t)T_TOK * DM * 2;
constexpr size_t WS_CTL = 0, CTL_BYTES = 32768;
constexpr size_t WS_XBUF = 32768;
constexpr size_t WS_MOD = WS_XBUF + 2 * (size_t)T_TOK * 16;
constexpr size_t WS_BIAS = WS_MOD + 491520;
constexpr size_t WS_W13T = WS_BIAS + 40960;
constexpr size_t WS_W2T = WS_W13T + (size_t)5632 * 1024 * 2;
constexpr size_t WS_FNWT = WS_W2T + (size_t)1024 * 2816 * 2;
constexpr size_t WS_HYWINT = WS_FNWT + 2 * 2097152;
constexpr size_t WS_HYWOUTT = WS_HYWINT + 6291456;
constexpr size_t WS_RWT = WS_HYWOUTT + 2097152;
constexpr size_t WS_LORA1T = WS_RWT + 6291456;
constexpr size_t WS_WOT = WS_LORA1T + 1572864;
constexpr size_t WS_LORA2T = WS_WOT + 2097152;
constexpr size_t WS_CS256 = WS_LORA2T + 2621440;
constexpr size_t WS_SEQ256 = WS_CS256 + 262144;
constexpr size_t WS_SEQ2048 = WS_SEQ256 + 262144;
constexpr size_t WS_X = WS_SEQ2048 + 16777216;
constexpr size_t WS_H = WS_X + (size_t)T_TOK * DM * 4;
constexpr size_t WS_L1 = WS_H + SZ_TD2;
constexpr size_t WS_Y = WS_L1 + (size_t)T_TOK * 384 * 2;
constexpr size_t WS_S1 = WS_Y + SZ_TD2;
constexpr size_t WS_S2 = WS_S1 + 6 * SZ_TD2;
constexpr size_t WS_END = WS_S2 + 3 * SZ_TD2;
constexpr size_t WS_TB = WS_S1;
constexpr size_t WS_HCST = WS_S1;
constexpr size_t WS_FOUT = WS_S1 + 2 * SZ_TD2;
constexpr size_t WS_UT = WS_S1;
constexpr size_t WS_YO = WS_S1 + 3 * SZ_TD2;
constexpr size_t WS_YOT = WS_S1 + 4 * SZ_TD2;
constexpr size_t WS_KF2048 = WS_S2;
constexpr size_t WS_KF256 = WS_S2 + 16777216;
constexpr size_t WS_XM = WS_S1;
constexpr size_t WS_RKV = WS_S2;
constexpr size_t WS_G = WS_S1;
constexpr size_t WS_E = WS_S1 + SZ_TD2;
constexpr size_t WS_AA = WS_S1 + 3 * SZ_TD2;
constexpr size_t WS_OF = WS_S1 + 5 * SZ_TD2;
constexpr size_t WS_OB = WS_H;

struct Params { const float* in[45]; float* out; unsigned char* ws; };
typedef const float* const __attribute__((address_space(4)))* kin_t;
struct KP { kin_t k;
    __device__ __forceinline__ const float* in(int i) const { return k[i]; }
    __device__ __forceinline__ float* out() const { return (float*)k[45]; }
    __device__ __forceinline__ unsigned char* ws() const { return (unsigned char*)k[46]; } };

enum { I_XP = 0, I_XS, I_SF, I_SB, I_C, I_CCTX, I_ADAW, I_ADAB, I_NG, I_W1, I_W3, I_W2, I_FNW, I_FNB, I_HYWIN, I_HYBIN, I_HYCW, I_HYCB,
       I_HYFW1, I_HYFB1, I_HYFREQ, I_HYFW2, I_HYFB2, I_HYFW3, I_HYD, I_HYWOUT, I_HYBOUT, I_MIX, I_WR, I_WK, I_WV, I_WO, I_W0, I_RW1, I_RW2,
       I_A0, I_A1, I_A2, I_G1, I_G2, I_KK, I_KA, I_RK, I_LNW, I_LNB };

__device__ __forceinline__ unsigned cvt_pk_bf16(float lo, float hi) { unsigned r; asm volatile("v_cvt_pk_bf16_f32 %0, %1, %2" : "=v"(r) : "v"(lo), "v"(hi)); return r; }
__device__ __forceinline__ float bf2f(unsigned short b) { return __builtin_bit_cast(float, (unsigned)b << 16); }
__device__ __forceinline__ float bflo(unsigned w) { return __builtin_bit_cast(float, w << 16); }
__device__ __forceinline__ float bfhi(unsigned w) { return __builtin_bit_cast(float, w & 0xffff0000u); }
template <int CTRL> __device__ __forceinline__ float dpp_f(float v) { return __builtin_bit_cast(float, __builtin_amdgcn_mov_dpp(__builtin_bit_cast(int, v), CTRL, 0xf, 0xf, true)); }
__device__ __forceinline__ float sum4(float v) { v += dpp_f<0xB1>(v); v += dpp_f<0x4E>(v); return v; }
__device__ __forceinline__ float sum8(float v) { v = sum4(v); v += dpp_f<0x141>(v); return v; }
__device__ __forceinline__ float sum16(float v) { v = sum8(v); v += dpp_f<0x140>(v); return v; }
__device__ __forceinline__ float wave_sum(float v) {
    v = sum16(v);
    const int iv = __builtin_bit_cast(int, v);
    return (__builtin_bit_cast(float, __builtin_amdgcn_readlane(iv, 0)) + __builtin_bit_cast(float, __builtin_amdgcn_readlane(iv, 16)))
         + (__builtin_bit_cast(float, __builtin_amdgcn_readlane(iv, 32)) + __builtin_bit_cast(float, __builtin_amdgcn_readlane(iv, 48)));
}
__device__ __forceinline__ int cond_of(int r) { return r < 4096 ? 0 : 1 + ((r - 4096) >> 11); }
__device__ __forceinline__ void tile_seq(int tt, int& start, int& L, int& l0) {
    if (tt < 16) { start = tt * 256; L = 256; l0 = 0; } else { const int j = (tt - 16) >> 3; start = 4096 + j * 2048; L = 2048; l0 = ((tt - 16) & 7) * 256; }
}
__device__ __forceinline__ float sigmoidf_(float x) { return __builtin_amdgcn_rcpf(1.f + __expf(-x)); }

constexpr int BK = 64, HALF = 128, HTB = HALF * BK * 2;
__device__ __forceinline__ int lds_byte(int r, int c) { const int st = (r >> 4) * 2 + (c >> 5), rr = r & 15, cc = c & 31, ob = rr * 64 + cc * 2; return st * 1024 + (ob ^ (((ob >> 9) & 1) << 5)); }
__device__ __forceinline__ void stage_rc(int b, int& R, int& C) { const int st = b / 1024, sb = b % 1024, swz = sb ^ (((sb >> 9) & 1) << 5); R = (st >> 1) * 16 + swz / 64; C = (st & 1) * 32 + (swz % 64) / 2; }

struct Unit { const char* A; const char* B; char* O; const float* bcol; const float* brow; int ldc; int mode; };
enum { EM_PLAIN = 0, EM_SWIGLU = 1, EM_TANH128 = 2, EM_SIG128 = 3, EM_ID128 = 4, EM_DECAY = 5, EM_SIGB = 6, EM_FUSED = 7 };
enum { PH_FG3_ = 11, PH_HG2_ = 13, PH_NG2_ = 18 };

struct EpiGen {
    int code, l, c; KP p;
    __device__ __forceinline__ void exchange(int ex, int pm, int pn, unsigned want, LAS float* P, LAS float* S, int wid, int lane) const {
        const int tid = wid * 64 + lane; unsigned char* ws = p.ws();
        float* xbuf = (float*)(ws + WS_XBUF) + (size_t)ex * T_TOK * 4; unsigned* cnt = (unsigned*)(ws + WS_CTL + 16384) + (ex * 48 + pm) * 16;
        asm volatile("s_waitcnt lgkmcnt(0)" ::: "memory"); __builtin_amdgcn_s_barrier(); asm volatile("" ::: "memory");
        if (tid < 256) { const LAS f32x4* pr = (const LAS f32x4*)(P + tid * 16); const f32x4 a = pr[0], b = pr[1], cc = pr[2], d = pr[3];
            const float tot = ((a[0] + a[1]) + (a[2] + a[3])) + ((b[0] + b[1]) + (b[2] + b[3])) + ((cc[0] + cc[1]) + (cc[2] + cc[3])) + ((d[0] + d[1]) + (d[2] + d[3]));
            __hip_atomic_store(xbuf + (size_t)(pm * 256 + tid) * 4 + pn, tot, __ATOMIC_RELAXED, __HIP_MEMORY_SCOPE_AGENT); }
        asm volatile("s_waitcnt vmcnt(0)" ::: "memory");
        if (wid < 4 && lane == 0) __hip_atomic_fetch_add(cnt, 1u, __ATOMIC_RELAXED, __HIP_MEMORY_SCOPE_AGENT);
        if (wid == 0) { unsigned spins = 0;
            while ((unsigned)__builtin_amdgcn_readfirstlane(__hip_atomic_load(cnt, __ATOMIC_RELAXED, __HIP_MEMORY_SCOPE_AGENT)) < want) { __builtin_amdgcn_s_sleep(1); if (++spins > (1u << 15)) break; }
            __builtin_amdgcn_fence(__ATOMIC_ACQUIRE, "agent"); }
        asm volatile("s_waitcnt vmcnt(0) lgkmcnt(0)" ::: "memory"); __builtin_amdgcn_s_barrier(); asm volatile("" ::: "memory");
        if (tid < 256) { const float* sl = xbuf + (size_t)(pm * 256 + tid) * 4; float t = 0.f;
#pragma unroll
            for (int k = 0; k < 4; ++k) t += __hip_atomic_load(sl + k, __ATOMIC_RELAXED, __HIP_MEMORY_SCOPE_AGENT);
            S[tid] = rsqrtf(t * (1.f / 1024.f) + 1e-6f); }
        asm volatile("s_waitcnt lgkmcnt(0)" ::: "memory"); __builtin_amdgcn_s_barrier(); asm volatile("" ::: "memory");
    }
    __device__ __forceinline__ void fused(f32x4 (&acc)[2][2][4][2], int wr, int wc, int fr, int fq, LAS unsigned char* lds, int wid, int lane) const {
        unsigned char* ws = p.ws();
        const int uu = (c >> 5) * 24 + (c & 31), pm = uu >> 2, pn = uu & 3, cond = pm < 16 ? 0 : 1 + ((pm - 16) >> 3);
        const bool mid = code != PH_NG2_, has_next = mid || l < 3;
        const float* modl = (const float*)(ws + WS_MOD) + ((size_t)l * 5 + cond) * 6144; const float* ngl = p.in(I_NG) + l * 4096;
        const float* gate = modl + (mid ? 2048 : 5120); const float* ngp = ngl + (mid ? 1024 : 3072);
        const float* bias = code == PH_FG3_ ? p.in(I_FNB) + (l / 3) * 1024 : (code == PH_HG2_ ? p.in(I_HYBOUT) : nullptr);
        const float* xsrc = (mid && l == 0) ? (pm < 16 ? p.in(I_XP) + (size_t)pm * 262144 : p.in(I_XS) + (size_t)(pm - 16) * 262144) : (const float*)(ws + WS_X) + (size_t)pm * 262144;
        float* xdst = (!mid && l == 3) ? p.out() + (size_t)pm * 262144 : (float*)(ws + WS_X) + (size_t)pm * 262144;
        bf16_t* hdst = (bf16_t*)(ws + WS_H) + (size_t)pm * 262144;
        LAS float* P = (LAS float*)(lds + 131072); LAS float* S = P + 4096;
        const int col0 = pn * 256 + wc * 32 + 4 * fq; const unsigned want = 16u * (unsigned)(2 * l + (mid ? 1 : 2));
        { float sq[2][4];
#pragma unroll
          for (int ai = 0; ai < 2; ++ai)
#pragma unroll
            for (int m = 0; m < 4; ++m) sq[ai][m] = 0.f;
#pragma unroll
          for (int bj = 0; bj < 2; ++bj)
#pragma unroll
            for (int n = 0; n < 2; ++n) { f32x4 bvec = {0.f, 0.f, 0.f, 0.f}; if (bias) bvec = *(const f32x4*)(bias + col0 + bj * 128 + n * 16);
#pragma unroll
                for (int ai = 0; ai < 2; ++ai)
#pragma unroll
                    for (int m = 0; m < 4; ++m) { const f32x4 v = acc[ai][bj][m][n] + bvec; acc[ai][bj][m][n] = v; sq[ai][m] += (v[0] * v[0] + v[1] * v[1]) + (v[2] * v[2] + v[3] * v[3]); } }
#pragma unroll
          for (int ai = 0; ai < 2; ++ai)
#pragma unroll
            for (int m = 0; m < 4; ++m) P[(ai * 128 + wr * 64 + m * 16 + fr) * 16 + wc * 4 + fq] = sq[ai][m]; }
        exchange(0, pm, pn, want, P, S, wid, lane);
        { f32x4 g4[2][2];
#pragma unroll
          for (int bj = 0; bj < 2; ++bj)
#pragma unroll
            for (int n = 0; n < 2; ++n) g4[bj][n] = *(const f32x4*)(gate + col0 + bj * 128 + n * 16) * *(const f32x4*)(ngp + col0 + bj * 128 + n * 16);
#pragma unroll
          for (int ai = 0; ai < 2; ++ai)
#pragma unroll
            for (int m = 0; m < 4; ++m) { const int row = ai * 128 + wr * 64 + m * 16 + fr; const float rs = S[row]; float sq = 0.f;
                f32x4 xv[2][2];
#pragma unroll
                for (int bj = 0; bj < 2; ++bj)
#pragma unroll
                    for (int n = 0; n < 2; ++n) xv[bj][n] = *(const f32x4*)(xsrc + (size_t)row * 1024 + col0 + bj * 128 + n * 16);
#pragma unroll
                for (int bj = 0; bj < 2; ++bj)
#pragma unroll
                    for (int n = 0; n < 2; ++n) { const size_t off = (size_t)row * 1024 + col0 + bj * 128 + n * 16; const f32x4 x = xv[bj][n];
                        const f32x4 xn = x + g4[bj][n] * (acc[ai][bj][m][n] * rs); acc[ai][bj][m][n] = xn; *(f32x4*)(xdst + off) = xn; sq += (xn[0] * xn[0] + xn[1] * xn[1]) + (xn[2] * xn[2] + xn[3] * xn[3]); }
                asm volatile("" : "+v"(acc[ai][0][m][0]), "+v"(acc[ai][0][m][1]), "+v"(acc[ai][1][m][0]), "+v"(acc[ai][1][m][1]));
                if (has_next) P[row * 16 + wc * 4 + fq] = sq;
                if (m & 1) asm volatile("" ::: "memory"); } }
        if (!has_next) return;
        exchange(1, pm, pn, want, P, S, wid, lane);
        { const float* ngn = mid ? ngl + 2048 : ngl + 4096; const float* scn = mid ? modl + 4096 : modl + 5 * 6144 + 1024; const float* shn = mid ? modl + 3072 : modl + 5 * 6144;
          f32x4 a4[2][2], s4[2][2];
#pragma unroll
          for (int bj = 0; bj < 2; ++bj)
#pragma unroll
            for (int n = 0; n < 2; ++n) { const int cc = col0 + bj * 128 + n * 16; a4[bj][n] = *(const f32x4*)(ngn + cc) * (1.f + *(const f32x4*)(scn + cc)); s4[bj][n] = *(const f32x4*)(shn + cc); }
#pragma unroll
          for (int ai = 0; ai < 2; ++ai)
#pragma unroll
            for (int m = 0; m < 4; ++m) { const int row = ai * 128 + wr * 64 + m * 16 + fr; const float rs = S[row];
#pragma unroll
                for (int bj = 0; bj < 2; ++bj)
#pragma unroll
                    for (int n = 0; n < 2; ++n) { const f32x4 hv = acc[ai][bj][m][n] * rs * a4[bj][n] + s4[bj][n]; u32x2 w; w.x = cvt_pk_bf16(hv[0], hv[1]); w.y = cvt_pk_bf16(hv[2], hv[3]);
                        *(u32x2*)(hdst + (size_t)row * 1024 + col0 + bj * 128 + n * 16) = w; } } }
    }
    __device__ __forceinline__ void operator()(f32x4 (&acc)[2][2][4][2], const Unit& u, int wr, int wc, int fr, int fq, LAS unsigned char* lds, int wid, int lane) const {
        if (u.mode == EM_FUSED) { fused(acc, wr, wc, fr, fq, lds, wid, lane); return; }
        bf16_t* O = (bf16_t*)u.O; const int ldc = u.ldc, mode = u.mode;
        if (mode == EM_SWIGLU) {
#pragma unroll
            for (int ai = 0; ai < 2; ++ai)
#pragma unroll
                for (int m = 0; m < 4; ++m) {
                    const int row = ai * HALF + wr * 64 + m * 16 + fr;
#pragma unroll
                    for (int bj = 0; bj < 2; ++bj) {
                        const f32x4 a = acc[ai][bj][m][0], b = acc[ai][bj][m][1]; f32x4 o;
#pragma unroll
                        for (int e = 0; e < 4; ++e) o[e] = a[e] * sigmoidf_(a[e]) * b[e];
                        u32x2 w; w.x = cvt_pk_bf16(o[0], o[1]); w.y = cvt_pk_bf16(o[2], o[3]);
                        *(u32x2*)(O + (size_t)row * ldc + bj * 64 + wc * 16 + fq * 4) = w;
                    }
                }
            return;
        }
        const bool half_only = (mode == EM_TANH128 || mode == EM_SIG128 || mode == EM_ID128);
#pragma unroll
        for (int ai = 0; ai < 2; ++ai)
#pragma unroll
            for (int m = 0; m < 4; ++m) {
                const int row = ai * HALF + wr * 64 + m * 16 + fr;
                const float br = u.brow ? u.brow[row] : 0.f;
#pragma unroll
                for (int bj = 0; bj < 2; ++bj) {
                    if (half_only && bj == 1) continue;
#pragma unroll
                    for (int n = 0; n < 2; ++n) {
                        const int col = bj * HALF + wc * 32 + n * 16 + fq * 4;
                        f32x4 v = acc[ai][bj][m][n];
                        if (u.bcol) v += *(const f32x4*)(u.bcol + col);
                        v += br;
                        if (mode == EM_TANH128) {
#pragma unroll
                            for (int e = 0; e < 4; ++e) v[e] = 1.f - 2.f * __builtin_amdgcn_rcpf(1.f + __expf(2.f * v[e]));
                        } else if (mode == EM_SIG128 || mode == EM_SIGB) {
#pragma unroll
                            for (int e = 0; e < 4; ++e) v[e] = sigmoidf_(v[e]);
                        } else if (mode == EM_DECAY) {
#pragma unroll
                            for (int e = 0; e < 4; ++e) v[e] = 0.60653066f * sigmoidf_(v[e]);
                        }
                        u32x2 w; w.x = cvt_pk_bf16(v[0], v[1]); w.y = cvt_pk_bf16(v[2], v[3]);
                        *(u32x2*)(O + (size_t)row * ldc + col) = w;
                    }
                }
            }
    }
};

template <bool ALIGN_EPI, class Sched, class Epi>
__device__ __forceinline__ void gemm_phase(const int tid, LAS unsigned char* lds, const int lda, const int ldb, const int nt, const Sched& S, const Epi& E) {
    const int wid = __builtin_amdgcn_readfirstlane(tid >> 6), lane = tid & 63, wr = wid >> 2, wc = wid & 3, fr = lane & 15, fq = lane >> 4;
    unsigned voffA[2], voffB[2];
#pragma unroll
    for (int i = 0; i < 2; ++i) { int R, C; stage_rc(tid * 16 + i * 8192, R, C); voffA[i] = (unsigned)(R * lda + C) * 2u; voffB[i] = (unsigned)(R * ldb + C) * 2u; }
    const size_t kstep = (size_t)(BK * 2);
    const size_t hstepA = (size_t)HALF * lda * 2, hstepB = (size_t)HALF * ldb * 2;
    const unsigned ldsw = (unsigned)wid * 1024u;
    const int aoff = lds_byte(wr * 64 + fr, fq * 8), boff = lds_byte(wc * 32 + fr, fq * 8);
#define PG8_SA(b, h) (((b) * 2 + (h)) * HTB)
#define PG8_SB(b, h) ((4 + (b) * 2 + (h)) * HTB)
#define PG8_STAGE(bufoff, gbase, voff) do { _Pragma("unroll") for (int _i = 0; _i < 2; ++_i) \
        __builtin_amdgcn_global_load_lds((const unsigned*)((const char*)(gbase) + (voff)[_i]), (LAS unsigned*)(lds + (bufoff) + ldsw + _i * 8192), 16, 0, 0); } while (0)
#define PG8_LDA(dst, b, h) do { _Pragma("unroll") for (int m = 0; m < 4; ++m) _Pragma("unroll") for (int k = 0; k < 2; ++k) dst[m][k] = *(const LAS bf16x8*)(lds + PG8_SA(b, h) + aoff + m * 2048 + k * 1024); } while (0)
#define PG8_LDB(dst, b, h) do { _Pragma("unroll") for (int n = 0; n < 2; ++n) _Pragma("unroll") for (int k = 0; k < 2; ++k) dst[n][k] = *(const LAS bf16x8*)(lds + PG8_SB(b, h) + boff + n * 2048 + k * 1024); } while (0)
#define PG8_MMA(ai, bj, At, Bt) do { __builtin_amdgcn_s_setprio(1); _Pragma("unroll") for (int m = 0; m < 4; ++m) _Pragma("unroll") for (int n = 0; n < 2; ++n) _Pragma("unroll") for (int k = 0; k < 2; ++k) \
        acc[ai][bj][m][n] = __builtin_amdgcn_mfma_f32_16x16x32_bf16(Bt[n][k], At[m][k], acc[ai][bj][m][n], 0, 0, 0); __builtin_amdgcn_s_setprio(0); } while (0)
#define PG8_WAIT_V(n) asm volatile("s_waitcnt vmcnt(" #n ")" ::: "memory")
#define PG8_WAIT_L(n) asm volatile("s_waitcnt lgkmcnt(" #n ")" ::: "memory")
#define PG8_BAR __builtin_amdgcn_s_barrier()
#define PG8_SCHED __builtin_amdgcn_sched_barrier(0)
    Unit cur, nxt; int ui = 0;
    if (!S.next(0, cur)) return;
    f32x4 acc[2][2][4][2];
#pragma unroll
    for (int a = 0; a < 2; ++a)
#pragma unroll
        for (int b = 0; b < 2; ++b)
#pragma unroll
            for (int m = 0; m < 4; ++m)
#pragma unroll
                for (int n = 0; n < 2; ++n) acc[a][b][m][n] = (f32x4){0.f, 0.f, 0.f, 0.f};
    bf16x8 At[4][2], B0[2][2], B1[2][2];
    const char* cA = cur.A; const char* cB = cur.B;
    PG8_STAGE(PG8_SB(0, 0), cB, voffB); PG8_STAGE(PG8_SB(0, 1), cB + hstepB, voffB); PG8_STAGE(PG8_SA(0, 0), cA, voffA); PG8_STAGE(PG8_SA(0, 1), cA + hstepA, voffA);
    if (wr == 1) PG8_BAR;
    PG8_WAIT_V(2); PG8_BAR;
    PG8_STAGE(PG8_SB(1, 0), cB + kstep, voffB); PG8_STAGE(PG8_SA(1, 0), cA + kstep, voffA); PG8_STAGE(PG8_SB(1, 1), cB + hstepB + kstep, voffB);
    PG8_WAIT_V(6); PG8_BAR;
    for (;;) {
        const bool has_next = S.next(ui + 1, nxt);
        const char* nA = has_next ? nxt.A : cA; const char* nB = has_next ? nxt.B : cB;
        for (int t = 0; t < nt; t += 2) {
            const bool last = (t == nt - 2);
            const char* a1 = cA + (size_t)(t + 1) * kstep;
            const char* a2 = last ? nA : cA + (size_t)(t + 2) * kstep; const char* b2 = last ? nB : cB + (size_t)(t + 2) * kstep;
            const char* a3 = a2 + kstep; const char* b3 = b2 + kstep;
            PG8_LDB(B0, 0, 0); PG8_LDB(B1, 0, 1); PG8_SCHED; PG8_LDA(At, 0, 0); PG8_STAGE(PG8_SA(1, 1), a1 + hstepA, voffA);
            PG8_WAIT_V(8); PG8_WAIT_L(0); PG8_BAR; PG8_MMA(0, 0, At, B0); PG8_MMA(0, 1, At, B1); PG8_BAR; PG8_SCHED;
            PG8_LDA(At, 0, 1); PG8_STAGE(PG8_SB(0, 0), b2, voffB); PG8_STAGE(PG8_SB(0, 1), b2 + hstepB, voffB); PG8_STAGE(PG8_SA(0, 0), a2, voffA);
            PG8_WAIT_V(8); PG8_WAIT_L(0); PG8_BAR; PG8_MMA(1, 0, At, B0); PG8_MMA(1, 1, At, B1); PG8_BAR; PG8_SCHED;
            PG8_LDB(B0, 1, 0); PG8_LDB(B1, 1, 1); PG8_SCHED; PG8_LDA(At, 1, 0); PG8_STAGE(PG8_SA(0, 1), a2 + hstepA, voffA);
            PG8_WAIT_V(8); PG8_WAIT_L(0); PG8_BAR; PG8_MMA(0, 0, At, B0); PG8_MMA(0, 1, At, B1); PG8_BAR; PG8_SCHED;
            PG8_LDA(At, 1, 1); PG8_STAGE(PG8_SB(1, 0), b3, voffB); PG8_STAGE(PG8_SB(1, 1), b3 + hstepB, voffB); PG8_STAGE(PG8_SA(1, 0), a3, voffA);
            PG8_WAIT_V(8); PG8_WAIT_L(0); PG8_BAR; PG8_MMA(1, 0, At, B0); PG8_MMA(1, 1, At, B1); PG8_BAR; PG8_SCHED;
        }
        if constexpr (ALIGN_EPI) { if (wr == 0) PG8_BAR; }
        { Unit eu; (void)S.next(ui, eu); int fr2 = fr, fq2 = fq, lane2 = lane, wr2 = wr, wc2 = wc, wid2 = wid; asm volatile("" : "+v"(fr2), "+v"(fq2), "+v"(lane2), "+s"(wr2), "+s"(wc2), "+s"(wid2));
          E(acc, eu, wr2, wc2, fr2, fq2, lds, wid2, lane2); }
        if (!has_next) break;
#pragma unroll
        for (int a = 0; a < 2; ++a)
#pragma unroll
            for (int b = 0; b < 2; ++b)
#pragma unroll
                for (int m = 0; m < 4; ++m)
#pragma unroll
                    for (int n = 0; n < 2; ++n) acc[a][b][m][n] = (f32x4){0.f, 0.f, 0.f, 0.f};
        cur = nxt; cA = nA; cB = nB; ++ui;
        if constexpr (ALIGN_EPI) { if (wr == 1) PG8_BAR; }
    }
    PG8_WAIT_V(0);
    if constexpr (!ALIGN_EPI) { if (wr == 0) PG8_BAR; }
    PG8_BAR;
#undef PG8_SA
#undef PG8_SB
#undef PG8_STAGE
#undef PG8_LDA
#undef PG8_LDB
#undef PG8_MMA
#undef PG8_WAIT_V
#undef PG8_WAIT_L
#undef PG8_BAR
#undef PG8_SCHED
}

enum { PH_PREP = 0, PH_R0 = 1, PH_RMID = 2, PH_REND = 3, PH_HC = 4, PH_RS = 5, PH_RP = 6, PH_HT = 7, PH_MIX = 19,
       PH_FG1 = 8, PH_FG2S = 9, PH_FG2P = 10, PH_FG3 = 11, PH_HG1 = 12, PH_HG2 = 13, PH_RG1 = 14, PH_RG2 = 15, PH_RG3 = 16, PH_NG1 = 17, PH_NG2 = 18 };
struct SchedAny {
    int code, l, G, c; unsigned char* ws; bool fuse;
    __device__ __forceinline__ bool next(int i, Unit& u) const {
        int L = i * G + c; const char* w = (const char*)ws; const float* bias = (const float*)(ws + WS_BIAS);
        u.bcol = nullptr; u.brow = nullptr; u.mode = EM_PLAIN; u.ldc = 1024;
        switch (code) {
        case PH_FG1: {
            if (L >= 384) return false;
            const int tt = L >> 3, rem = L & 7, g = rem >> 1, pm = rem & 1; int start, Ls, l0; tile_seq(tt, start, Ls, l0);
            u.A = w + WS_CS256 + (size_t)pm * 256 * 256 * 2; u.B = w + WS_H + ((size_t)tt * 256 * 1024 + g * 256) * 2;
            u.O = (char*)ws + WS_HCST + ((size_t)start * 2048 + (size_t)(g * 512 + pm * 256) * Ls + l0) * 2; u.ldc = Ls; return true; }
        case PH_FG2S: {
            if (L >= 128) return false;
            const int j = L >> 5, rem = L & 31, pm = rem >> 2, pn = rem & 3; const size_t start = 4096 + (size_t)j * 2048;
            u.A = w + WS_SEQ2048 + (size_t)pm * 256 * 4096 * 2; u.B = w + WS_HCST + (start * 2048 + (size_t)pn * 256 * 4096) * 2;
            u.O = (char*)ws + WS_FOUT + ((start + pm * 256) * 1024 + pn * 256) * 2; return true; }
        case PH_FG2P: {
            const int cc = (c + G - (128 % G)) % G; L = i * G + cc; if (L >= 64) return false;
            const int s = L >> 2, pn = L & 3;
            u.A = w + WS_SEQ256; u.B = w + WS_HCST + ((size_t)s * 256 * 2048 + (size_t)pn * 256 * 512) * 2;
            u.O = (char*)ws + WS_FOUT + ((size_t)s * 256 * 1024 + pn * 256) * 2; return true; }
        case PH_HG1: {
            if (L >= 576) return false;
            const int tt = L / 12, pm = L - tt * 12; int start, Ls, l0; tile_seq(tt, start, Ls, l0);
            u.A = w + WS_HYWINT + (size_t)pm * 256 * 1024 * 2; u.B = w + WS_H + (size_t)tt * 256 * 1024 * 2;
            u.O = (char*)ws + WS_UT + ((size_t)start * 3072 + (size_t)pm * 256 * Ls + l0) * 2; u.ldc = Ls; u.brow = bias + 2048 + pm * 256; return true; }
        case PH_RG1: {
            if (L >= 720) return false;
            if (L < 576) { const int p = L / 192, r = L - p * 192, pm = r >> 2, pn = r & 3;
                u.A = w + WS_XM + (size_t)p * SZ_TD2 + (size_t)pm * 256 * 1024 * 2; u.B = w + WS_RWT + ((size_t)p * 1024 + pn * 256) * 1024 * 2;
                u.O = (char*)ws + WS_RKV + (size_t)p * SZ_TD2 + ((size_t)pm * 256 * 1024 + pn * 256) * 2;
            } else { const int q = L - 576, p = q / 48, pm = q - p * 48;
                u.A = w + WS_XM + (size_t)(3 + p) * SZ_TD2 + (size_t)pm * 256 * 1024 * 2; u.B = w + WS_LORA1T + (size_t)p * 256 * 1024 * 2;
                u.O = (char*)ws + WS_L1 + ((size_t)pm * 256 * 384 + p * 128) * 2; u.ldc = 384; u.mode = (p == 0) ? EM_TANH128 : (p == 1 ? EM_ID128 : EM_SIG128); }
            return true; }
        case PH_RG2: {
            if (L >= 960) return false;
            const int p = L / 192, r = L - p * 192, pm = r >> 2, pn = r & 3;
            u.A = w + WS_L1 + ((size_t)pm * 256 * 384 + (p == 4 ? 128 : 0)) * 2; u.B = w + WS_LORA2T + ((size_t)p * 1024 + pn * 256) * 256 * 2;
            const size_t o = ((size_t)pm * 256 * 1024 + pn * 256) * 2;
            if (p == 4) { u.O = (char*)ws + WS_G + o; }
            else if (p < 2) { u.O = (char*)ws + WS_E + (size_t)p * SZ_TD2 + o; u.bcol = bias + 6144 + p * 1024 + pn * 256; u.mode = EM_DECAY; }
            else { u.O = (char*)ws + WS_AA + (size_t)(p - 2) * SZ_TD2 + o; u.bcol = bias + 8192 + (p - 2) * 1024 + pn * 256; u.mode = EM_SIGB; }
            return true; }
        case PH_NG1: {
            if (L >= 1056) return false;
            const int pm = L / 22, pn = L - pm * 22;
            u.A = w + WS_H + (size_t)pm * 256 * 1024 * 2; u.B = w + WS_W13T + (size_t)pn * 256 * 1024 * 2;
            u.O = (char*)ws + WS_TB + ((size_t)pm * 256 * FF + pn * 128) * 2; u.ldc = FF; u.mode = EM_SWIGLU; return true; }
        default: {
            if (fuse) { if (i != 0 || (c & 31) >= 24) return false; L = (c >> 5) * 24 + (c & 31); }
            if (L >= 192) return false;
            const int pm = L >> 2, pn = L & 3; size_t a, b, k;
            if (code == PH_FG3) { a = WS_FOUT; b = WS_FNWT + (size_t)(l / 3) * 2097152; k = 1024; u.bcol = bias + (l / 3) * 1024 + pn * 256; }
            else if (code == PH_HG2) { a = WS_YO; b = WS_HYWOUTT; k = 1024; u.bcol = bias + 5120 + pn * 256; }
            else if (code == PH_RG3) { a = WS_OF; b = WS_WOT; k = 1024; }
            else { a = WS_TB; b = WS_W2T; k = FF; }
            u.A = w + a + (size_t)pm * 256 * k * 2; u.B = w + b + (size_t)pn * 256 * k * 2;
            u.O = (char*)ws + WS_Y + ((size_t)pm * 256 * 1024 + pn * 256) * 2; if (fuse) { u.mode = EM_FUSED; u.bcol = nullptr; } return true; }
        }
    }
};

__device__ __forceinline__ void transpose_item(const float* W, int N, bf16_t* WT, int dst_ld, int k_off, int mode, int row_off, LAS float* scr, int item, int lane) {
    const int nblk = N / 32, kb = item / nblk, nb = item - kb * nblk, k0 = 64 * kb, n0 = 32 * nb;
    { float wv[32];
#pragma unroll
      for (int i = 0; i < 32; ++i) wv[i] = __builtin_nontemporal_load(W + (size_t)(k0 + 2 * i + (lane >> 5)) * N + n0 + (lane & 31));
#pragma unroll
      for (int i = 0; i < 32; ++i) scr[(2 * i + (lane >> 5)) * 33 + (lane & 31)] = wv[i]; }
    asm volatile("s_waitcnt lgkmcnt(0)" ::: "memory");
    const int c = lane & 7;
#pragma unroll
    for (int j = 0; j < 4; ++j) { const int n = (lane >> 3) + 8 * j; const LAS float* s = scr + (8 * c) * 33 + n; const int nn = n0 + n;
        const int drow = (mode == 0) ? row_off + nn : ((nn >> 4) * 32 + (nn & 15) + (mode == 2 ? 16 : 0));
        u32x4 o; o.x = cvt_pk_bf16(s[0 * 33], s[1 * 33]); o.y = cvt_pk_bf16(s[2 * 33], s[3 * 33]); o.z = cvt_pk_bf16(s[4 * 33], s[5 * 33]); o.w = cvt_pk_bf16(s[6 * 33], s[7 * 33]);
        *(u32x4*)(WT + (size_t)drow * dst_ld + k_off + k0 + 8 * c) = o; }
    asm volatile("s_waitcnt lgkmcnt(0)" ::: "memory");
}

__device__ __forceinline__ void convert_ffn(const KP& p, int l, LAS float* scr, int gw, int NGW, int lane) {
    const float* w1 = p.in(I_W1) + (size_t)l * DM * FF; const float* w3 = p.in(I_W3) + (size_t)l * DM * FF; const float* w2 = p.in(I_W2) + (size_t)l * FF * DM;
    bf16_t* w13t = (bf16_t*)(p.ws() + WS_W13T); bf16_t* w2t = (bf16_t*)(p.ws() + WS_W2T);
    for (int it = gw; it < 4224; it += NGW) {
        int r = it;
        if (r < 1408) { transpose_item(w1, FF, w13t, 1024, 0, 1, 0, scr, r, lane); continue; } r -= 1408;
        if (r < 1408) { transpose_item(w3, FF, w13t, 1024, 0, 2, 0, scr, r, lane); continue; } r -= 1408;
        transpose_item(w2, DM, w2t, FF, 0, 0, 0, scr, r, lane);
    }
}

__device__ __forceinline__ void p0_transposes(const KP& p, LAS float* scr, int gw, int NGW, int lane) {
    unsigned char* ws = p.ws();
    for (int it = gw; it < 5504; it += NGW) {
        int r = it;
        if (r < 1024) { const int j = r >> 9; transpose_item(p.in(I_FNW) + (size_t)j * DM * DM, DM, (bf16_t*)(ws + WS_FNWT) + (size_t)j * DM * DM, 1024, 0, 0, 0, scr, r & 511, lane); continue; } r -= 1024;
        if (r < 1536) { transpose_item(p.in(I_HYWIN), 3072, (bf16_t*)(ws + WS_HYWINT), 1024, 0, 0, 0, scr, r, lane); continue; } r -= 1536;
        if (r < 512) { transpose_item(p.in(I_HYWOUT), DM, (bf16_t*)(ws + WS_HYWOUTT), 1024, 0, 0, 0, scr, r, lane); continue; } r -= 512;
        if (r < 1536) { const int j = r >> 9; transpose_item(p.in(I_WR + j), DM, (bf16_t*)(ws + WS_RWT) + (size_t)j * DM * DM, 1024, 0, 0, 0, scr, r & 511, lane); continue; } r -= 1536;
        if (r < 512) { transpose_item(p.in(I_WO), DM, (bf16_t*)(ws + WS_WOT), 1024, 0, 0, 0, scr, r, lane); continue; } r -= 512;
        if (r < 64) { const int d = r >> 5; transpose_item(p.in(I_RW1) + (size_t)d * DM * 64, 64, (bf16_t*)(ws + WS_LORA1T), 1024, 0, 0, d * 64, scr, r & 31, lane); continue; } r -= 64;
        if (r < 64) { const int d = r >> 5; transpose_item(p.in(I_A1) + (size_t)d * DM * 64, 64, (bf16_t*)(ws + WS_LORA1T) + 256 * 1024, 1024, 0, 0, d * 64, scr, r & 31, lane); continue; } r -= 64;
        if (r < 64) { transpose_item(p.in(I_G1), 128, (bf16_t*)(ws + WS_LORA1T) + 2 * 256 * 1024, 1024, 0, 0, 0, scr, r, lane); continue; } r -= 64;
        if (r < 64) { const int d = r >> 5; transpose_item(p.in(I_RW2) + (size_t)d * 64 * DM, DM, (bf16_t*)(ws + WS_LORA2T) + (size_t)d * 1024 * 256, 256, d * 64, 0, 0, scr, r & 31, lane); continue; } r -= 64;
        if (r < 64) { const int d = r >> 5; transpose_item(p.in(I_A2) + (size_t)d * 64 * DM, DM, (bf16_t*)(ws + WS_LORA2T) + (size_t)(2 + d) * 1024 * 256, 256, 128 + d * 64, 0, 0, scr, r & 31, lane); continue; } r -= 64;
        transpose_item(p.in(I_G2), DM, (bf16_t*)(ws + WS_LORA2T) + (size_t)4 * 1024 * 256, 256, 128, 0, 0, scr, r, lane);
    }
}

__device__ __forceinline__ void p0_tables(const KP& p, int gtid, int NT) {
    unsigned char* ws = p.ws();
    for (int it = gtid; it < 5 * 1024 * 32; it += NT) {
        const int m = it >> 15, rem = it & 32767, row = rem >> 5, ch = rem & 31, k = ch * 8;
        const int lo = (m == 0) ? 0 : (m == 1 ? 64 : (m == 2 ? 128 : (m == 3 ? 192 : 128))), hi = (m == 4) ? 256 : lo + 64;
        unsigned zz = 0u; asm volatile("" : "+v"(zz));
        if (k < lo || k >= hi) *(u32x4*)((bf16_t*)(ws + WS_LORA2T) + ((size_t)m * 1024 + row) * 256 + k) = (u32x4){zz, zz, zz, zz};
    }
    { float* bias = (float*)(ws + WS_BIAS);
      for (int it = gtid; it < 10240; it += NT) { float v;
          if (it < 2048) v = p.in(I_FNB)[it]; else if (it < 5120) v = p.in(I_HYBIN)[it - 2048]; else if (it < 6144) v = p.in(I_HYBOUT)[it - 5120]; else if (it < 8192) v = p.in(I_W0)[it - 6144]; else v = p.in(I_A0)[it - 8192];
          bias[it] = v; } }
    for (int it = gtid; it < 512 * 32; it += NT) {
        const int m = it >> 5, k0 = (it & 31) * 8, j = m >> 1, pp = m & 1; float v[8];
#pragma unroll
        for (int e = 0; e < 8; ++e) { const float fr = (float)((j * (k0 + e)) & 255) * (1.f / 256.f); v[e] = (pp ? __builtin_amdgcn_sinf(fr) : __builtin_amdgcn_cosf(fr)) * 0.0625f; }
        u32x4 o; o.x = cvt_pk_bf16(v[0], v[1]); o.y = cvt_pk_bf16(v[2], v[3]); o.z = cvt_pk_bf16(v[4], v[5]); o.w = cvt_pk_bf16(v[6], v[7]);
        *(u32x4*)((bf16_t*)(ws + WS_CS256) + (size_t)m * 256 + k0) = o;
    }
    for (int it = gtid; it < 256 * 64 + 2048 * 512; it += NT) {
        int L, lp, kc; bf16_t* dst;
        if (it < 256 * 64) { L = 256; lp = it >> 6; kc = (it & 63) * 8; dst = (bf16_t*)(ws + WS_SEQ256) + (size_t)lp * 512 + kc; }
        else { const int q = it - 256 * 64; L = 2048; lp = q >> 9; kc = (q & 511) * 8; dst = (bf16_t*)(ws + WS_SEQ2048) + (size_t)lp * 4096 + kc; }
        const int pp = kc >= L, l0 = kc - pp * L; const float invL = 1.f / (float)L, sc = (L == 256) ? 0.0625f : 0.022097087f; float v[8];
#pragma unroll
        for (int e = 0; e < 8; ++e) { const float fr = (float)((lp * (l0 + e)) & (L - 1)) * invL; v[e] = (pp ? -__builtin_amdgcn_sinf(fr) : __builtin_amdgcn_cosf(fr)) * sc; }
        u32x4 o; o.x = cvt_pk_bf16(v[0], v[1]); o.y = cvt_pk_bf16(v[2], v[3]); o.z = cvt_pk_bf16(v[4], v[5]); o.w = cvt_pk_bf16(v[6], v[7]);
        *(u32x4*)dst = o;
    }
}

__device__ __forceinline__ void p0_mod(const KP& p, const int tid, LAS float* lds_f, int c, int G) {
    LAS float* sc = lds_f;
    LAS float* part = lds_f + 5120;
    const int wid = tid >> 6, lane = tid & 63;
    for (int i = tid; i < 5120; i += NTHR) { const int cd = i >> 10, k = i & 1023; const float x = cd == 0 ? p.in(I_CCTX)[k] : p.in(I_C)[(cd - 1) * 1024 + k]; sc[i] = x * sigmoidf_(x); }
    __syncthreads();
    float* MOD = (float*)(p.ws() + WS_MOD);
    for (int it = c; it < 96; it += G) {
        const int l = it / 24, cg_ = it - l * 24;
        const float* W = p.in(I_ADAW) + (size_t)l * DM * 6144 + cg_ * 256 + lane * 4;
        f32x4 a0 = {0.f, 0.f, 0.f, 0.f}, a1 = a0, a2 = a0, a3 = a0, a4 = a0;
        const int kb = wid * 128;
#pragma unroll 1
        for (int k0 = 0; k0 < 128; k0 += 16) {
            f32x4 w[16];
#pragma unroll
            for (int j = 0; j < 16; ++j) w[j] = __builtin_nontemporal_load((const f32x4*)(W + (size_t)(kb + k0 + j) * 6144));
#pragma unroll
            for (int j = 0; j < 16; ++j) { const int k = kb + k0 + j; a0 += sc[k] * w[j]; a1 += sc[1024 + k] * w[j]; a2 += sc[2048 + k] * w[j]; a3 += sc[3072 + k] * w[j]; a4 += sc[4096 + k] * w[j]; }
        }
        *(LAS f32x4*)(part + (wid * 5 + 0) * 256 + lane * 4) = a0; *(LAS f32x4*)(part + (wid * 5 + 1) * 256 + lane * 4) = a1; *(LAS f32x4*)(part + (wid * 5 + 2) * 256 + lane * 4) = a2;
        *(LAS f32x4*)(part + (wid * 5 + 3) * 256 + lane * 4) = a3; *(LAS f32x4*)(part + (wid * 5 + 4) * 256 + lane * 4) = a4;
        __syncthreads();
        for (int o = tid; o < 1280; o += NTHR) { const int cd = o >> 8, ln = o & 255; float s_ = p.in(I_ADAB)[l * 6144 + cg_ * 256 + ln];
#pragma unroll
            for (int w = 0; w < 8; ++w) s_ += part[(w * 5 + cd) * 256 + ln];
            MOD[((size_t)l * 5 + cd) * 6144 + cg_ * 256 + ln] = s_; }
        __syncthreads();
    }
}

__device__ __forceinline__ void p0_hyfilter(const KP& p, const int tid, LAS float* lds_f, int c, int G) {
    LAS float* h1 = lds_f;
    LAS float* h2 = lds_f + 64 * 65;
    LAS float* w1s = h2 + 64 * 64;
    LAS float* w2s = w1s + 33 * 64;
    const float* w1 = p.in(I_HYFW1); const float* b1 = p.in(I_HYFB1); const float* fq = p.in(I_HYFREQ); const float* w2 = p.in(I_HYFW2); const float* b2 = p.in(I_HYFB2); const float* w3 = p.in(I_HYFW3);
    for (int i = tid; i < 33 * 64; i += NTHR) w1s[i] = w1[i];
    for (int i = tid; i < 64 * 64; i += NTHR) w2s[i] = w2[i];
    __syncthreads();
    for (int it = c; it < 144; it += G) {
        const int tc = it >> 2, cgp = it & 3; int L, t0; if (tc < 4) { L = 256; t0 = tc * 64; } else { L = 2048; t0 = (tc - 4) * 64; }
        float* KF = (float*)(p.ws() + (L == 256 ? WS_KF256 : WS_KF2048));
        {
            const int tl = tid >> 3, u0 = (tid & 7) * 8, t = t0 + tl; float a[8];
#pragma unroll
            for (int e = 0; e < 8; ++e) a[e] = b1[u0 + e];
            const float tf = (float)t / (float)(L - 1), ang = 6.283185307179586f * (float)t / (float)L;
#pragma unroll
            for (int e = 0; e < 8; ++e) a[e] += tf * w1s[u0 + e];
            for (int j = 0; j < 16; ++j) { const float band = 1e-4f + (float)j * ((15.f - 1e-4f) / 15.f); const float x = band * ang; const float cs = __cosf(x), sn = -__sinf(x);
#pragma unroll
                for (int e = 0; e < 8; ++e) a[e] += cs * w1s[(1 + j) * 64 + u0 + e] + sn * w1s[(17 + j) * 64 + u0 + e]; }
#pragma unroll
            for (int e = 0; e < 8; ++e) h1[tl * 65 + u0 + e] = __sinf(fq[u0 + e] * a[e]);
        }
        __syncthreads();
        {
            const int tl = tid >> 3, u0 = (tid & 7) * 8; float a[8];
#pragma unroll
            for (int e = 0; e < 8; ++e) a[e] = b2[u0 + e];
            for (int j = 0; j < 64; ++j) { const float hv = h1[tl * 65 + j];
#pragma unroll
                for (int e = 0; e < 8; ++e) a[e] += hv * w2s[j * 64 + u0 + e]; }
#pragma unroll
            for (int e = 0; e < 8; ++e) h2[tl * 64 + u0 + e] = __sinf(fq[64 + u0 + e] * a[e]);
        }
        __syncthreads();
        {
            const int cc = cgp * 512 + tid, d = cc & 1023; const bool bwd = cc >= 1024;
            float wc[64];
#pragma unroll
            for (int j = 0; j < 64; ++j) wc[j] = w3[j * 2048 + cc];
            const float da = -15.350567286626973f, db = -3.0701134573253945f; const float adel = fabsf(da + (float)d * ((db - da) / 1023.f));
            for (int tl = 0; tl < 64; tl += 4) {
                f32x4 vals;
#pragma unroll
                for (int q = 0; q < 4; ++q) { const int t = t0 + tl + q; float acc = 0.f;
#pragma unroll
                    for (int j = 0; j < 64; j += 4) { const f32x4 hv = *(const LAS f32x4*)(h2 + (tl + q) * 64 + j); acc += hv[0] * wc[j] + hv[1] * wc[j + 1] + hv[2] * wc[j + 2] + hv[3] * wc[j + 3]; }
                    vals[q] = acc * __expf(-((float)t / (float)(L - 1)) * adel); asm volatile("" ::: "memory"); }
                if (t0 + tl == 0) { if (bwd) vals[0] = 0.f; else { float acc2 = 0.f; for (int j = 0; j < 64; ++j) acc2 += h2[j] * w3[j * 2048 + cc + 1024]; vals[0] += acc2; } }
                *(f32x4*)(KF + (size_t)d * 2 * L + (bwd ? L : 0) + t0 + tl) = vals;
            }
        }
        __syncthreads();
    }
}

struct RowCfg {
    const float* xs_p; const float* xs_s;
    float* xdst;
    const bf16_t* y;
    const float* gate; const float* ng_post;
    const float* ng_pre; const float* sc; const float* sh;
    bf16_t* h;
    const float* mix; bf16_t* xm;
};
__device__ __forceinline__ void compute_row(const RowCfg& cf, int r, int lane, bool store, f32x4 (&hv)[4]) {
    const float* xr = (r < 4096) ? cf.xs_p + (size_t)r * 1024 : cf.xs_s + (size_t)(r - 4096) * 1024;
    const int cd = cond_of(r); f32x4 x[4];
#pragma unroll
    for (int j = 0; j < 4; ++j) x[j] = *(const f32x4*)(xr + 4 * lane + 256 * j);
    if (cf.y) {
        f32x4 yv[4]; float ss = 0.f;
#pragma unroll
        for (int j = 0; j < 4; ++j) { const u32x2 w = *(const u32x2*)(cf.y + (size_t)r * 1024 + 4 * lane + 256 * j); yv[j] = (f32x4){bflo(w.x), bfhi(w.x), bflo(w.y), bfhi(w.y)};
            ss += (yv[j][0] * yv[j][0] + yv[j][1] * yv[j][1]) + (yv[j][2] * yv[j][2] + yv[j][3] * yv[j][3]); }
        const float rstd = rsqrtf(wave_sum(ss) * (1.f / 1024.f) + 1e-6f);
#pragma unroll
        for (int j = 0; j < 4; ++j) { const f32x4 gt = *(const f32x4*)(cf.gate + cd * 6144 + 4 * lane + 256 * j), ng = *(const f32x4*)(cf.ng_post + 4 * lane + 256 * j);
            x[j] += gt * (yv[j] * rstd * ng); }
        if (store && cf.xdst) {
#pragma unroll
            for (int j = 0; j < 4; ++j) *(f32x4*)(cf.xdst + (size_t)r * 1024 + 4 * lane + 256 * j) = x[j];
        }
    }
    if (cf.ng_pre) {
        f32x4 ngv[4], s1v[4], s0v[4];
#pragma unroll
        for (int j = 0; j < 4; ++j) { const int cc = 4 * lane + 256 * j; ngv[j] = *(const f32x4*)(cf.ng_pre + cc); s1v[j] = *(const f32x4*)(cf.sc + cd * 6144 + cc); s0v[j] = *(const f32x4*)(cf.sh + cd * 6144 + cc); }
        float ss = 0.f;
#pragma unroll
        for (int j = 0; j < 4; ++j) ss += (x[j][0] * x[j][0] + x[j][1] * x[j][1]) + (x[j][2] * x[j][2] + x[j][3] * x[j][3]);
        const float rstd = rsqrtf(wave_sum(ss) * (1.f / 1024.f) + 1e-6f);
#pragma unroll
        for (int j = 0; j < 4; ++j) hv[j] = x[j] * rstd * ngv[j] * (1.f + s1v[j]) + s0v[j];
    }
}
template <bool RW>
__device__ __forceinline__ void row_phase(const RowCfg& cf, int gw, int NGW, int lane) {
    if constexpr (!RW) {
        for (int r = gw; r < T_TOK; r += NGW) {
            f32x4 hv[4]; compute_row(cf, r, lane, true, hv);
            if (cf.ng_pre) {
#pragma unroll
                for (int j = 0; j < 4; ++j) { u32x2 w; w.x = cvt_pk_bf16(hv[j][0], hv[j][1]); w.y = cvt_pk_bf16(hv[j][2], hv[j][3]); *(u32x2*)(cf.h + (size_t)r * 1024 + 4 * lane + 256 * j) = w; }
            }
        }
    } else {
        const int slot[6] = {0, 3, 1, 2, 4, 5};
        for (int st = gw; st < T_TOK / 4; st += NGW) {
            const int t0 = st * 4; int s0, s1;
            if (t0 < 4096) { s0 = t0 & ~255; s1 = s0 + 256; } else { s0 = 4096 + ((t0 - 4096) & ~2047); s1 = s0 + 2048; }
            f32x4 hp[4], hc[4], hn[4];
            if (t0 - 1 >= s0) compute_row(cf, t0 - 1, lane, false, hp); else {
#pragma unroll
                for (int j = 0; j < 4; ++j) hp[j] = (f32x4){0.f, 0.f, 0.f, 0.f}; }
            compute_row(cf, t0, lane, true, hc);
#pragma unroll 1
            for (int i = 0; i < 4; ++i) {
                const int t = t0 + i;
                if (t + 1 < s1) compute_row(cf, t + 1, lane, i < 3, hn); else {
#pragma unroll
                    for (int j = 0; j < 4; ++j) hn[j] = (f32x4){0.f, 0.f, 0.f, 0.f}; }
#pragma unroll
                for (int j = 0; j < 4; ++j) { const int cc = 4 * lane + 256 * j; const f32x4 xx = 0.5f * (hp[j] + hn[j]) - hc[j];
#pragma unroll
                    for (int m = 0; m < 6; ++m) { const f32x4 mx = *(const f32x4*)(cf.mix + m * 1024 + cc); const f32x4 v = hc[j] + xx * mx;
                        u32x2 w; w.x = cvt_pk_bf16(v[0], v[1]); w.y = cvt_pk_bf16(v[2], v[3]);
                        *(u32x2*)(cf.xm + (size_t)slot[m] * T_TOK * 1024 + (size_t)t * 1024 + cc) = w; } }
#pragma unroll
                for (int j = 0; j < 4; ++j) { hp[j] = hc[j]; hc[j] = hn[j]; }
            }
        }
    }
}

typedef float f32x16 __attribute__((ext_vector_type(16)));
__device__ __forceinline__ float shortconv(const bf16_t* row, int t, int L, float c0, float c1, float c2, float cb) {
    const float um = t > 0 ? bf2f(row[t - 1]) : 0.f, u0 = bf2f(row[t]), up = t + 1 < L ? bf2f(row[t + 1]) : 0.f;
    return c0 * um + c1 * u0 + c2 * up + cb;
}
__device__ __forceinline__ f32x16 conv_mfma(const LAS unsigned char* rk, int rkstride, const LAS unsigned char* z, int zs, int L, int I0, int dlo, int dhi, int lane) {
    const int i = lane & 31, h = lane >> 5, s = (-i) & 7, bl = (lane >> 3) & 3, Jl = lane & 7;
    const LAS unsigned char* ap = rk + s * rkstride + (L - i - s + h * 8) * 2;
    const LAS unsigned char* bp = z + bl * zs + ((Jl + 7) * 32 + h * 8) * 2;
    f32x16 acc;
#pragma unroll
    for (int e = 0; e < 16; ++e) acc[e] = 0.f;
#pragma unroll 2
    for (int dl = dlo; dl <= dhi; ++dl) {
        const LAS unsigned char* a0 = ap - dl * 64; const LAS unsigned char* b0 = bp + (I0 - dl) * 64;
        const bf16x8 av0 = *(const LAS bf16x8*)a0, bv0 = *(const LAS bf16x8*)b0, av1 = *(const LAS bf16x8*)(a0 + 32), bv1 = *(const LAS bf16x8*)(b0 + 32);
        acc = __builtin_amdgcn_mfma_f32_32x32x16_bf16(av0, bv0, acc, 0, 0, 0);
        acc = __builtin_amdgcn_mfma_f32_32x32x16_bf16(av1, bv1, acc, 0, 0, 0);
    }
    return acc;
}
template <int L, int NBAT, int NT_>
struct HyCh {
    f32x4 kf[2]; u32x4 um[2][3]; unsigned pv[2][3], nx[2][3];
    __device__ __forceinline__ void load(const KP& p, int t, int tok0, int d) {
        const float* KF = (const float*)(p.ws() + (L == 256 ? WS_KF256 : WS_KF2048)) + (size_t)d * 2 * L;
#pragma unroll
        for (int k = 0; k < 2; ++k) { const int j = t + k * NT_; if (j < 2 * L / 4) kf[k] = *(const f32x4*)(KF + 4 * j); }
        const bf16_t* UT = (const bf16_t*)(p.ws() + WS_UT);
#pragma unroll
        for (int k = 0; k < 2; ++k) { const int it = t + k * NT_, b = it / (L / 8), t0 = (it - b * (L / 8)) * 8;
#pragma unroll
            for (int r = 0; r < 3; ++r) { const bf16_t* row = UT + (size_t)(tok0 + b * L) * 3072 + (size_t)(r * 1024 + d) * L;
                um[k][r] = *(const u32x4*)(row + t0); pv[k][r] = row[t0 > 0 ? t0 - 1 : 0]; nx[k][r] = row[t0 + 8 < L ? t0 + 8 : t0]; } }
    }
    __device__ __forceinline__ void store(const KP& p, int t, int d, LAS unsigned char* rk0, LAS unsigned char* z, int zs, LAS bf16_t* x0) const {
#pragma unroll
        for (int k = 0; k < 2; ++k) { const int j = t + k * NT_; if (j < 2 * L / 4) {
#pragma unroll
                for (int e = 0; e < 4; ++e) { const int i = 4 * j + e, circ = i <= L ? i : 3 * L - i;
                    *(LAS bf16_t*)(rk0 + ((L - circ) & (2 * L - 1)) * 2) = (bf16_t)(cvt_pk_bf16(kf[k][e], 0.f) & 0xffffu); } } }
        const float* cw = p.in(I_HYCW); const float* cb = p.in(I_HYCB); float c0[3], c1[3], c2[3], cbv[3];
#pragma unroll
        for (int r = 0; r < 3; ++r) { c0[r] = cw[r * 1024 + d]; c1[r] = cw[3072 + r * 1024 + d]; c2[r] = cw[6144 + r * 1024 + d]; cbv[r] = cb[r * 1024 + d]; }
#pragma unroll
        for (int k = 0; k < 2; ++k) { const int it = t + k * NT_, b = it / (L / 8), t0 = (it - b * (L / 8)) * 8; float cv[3][8];
#pragma unroll
            for (int r = 0; r < 3; ++r) { float u[10]; u[0] = t0 > 0 ? bflo(pv[k][r]) : 0.f; u[9] = t0 + 8 < L ? bflo(nx[k][r]) : 0.f;
                u[1] = bflo(um[k][r].x); u[2] = bfhi(um[k][r].x); u[3] = bflo(um[k][r].y); u[4] = bfhi(um[k][r].y); u[5] = bflo(um[k][r].z); u[6] = bfhi(um[k][r].z); u[7] = bflo(um[k][r].w); u[8] = bfhi(um[k][r].w);
#pragma unroll
                for (int e = 0; e < 8; ++e) cv[r][e] = c0[r] * u[e] + c1[r] * u[e + 1] + c2[r] * u[e + 2] + cbv[r]; }
            u32x4 zo, xo;
            zo.x = cvt_pk_bf16(cv[2][0] * cv[1][0], cv[2][1] * cv[1][1]); zo.y = cvt_pk_bf16(cv[2][2] * cv[1][2], cv[2][3] * cv[1][3]); zo.z = cvt_pk_bf16(cv[2][4] * cv[1][4], cv[2][5] * cv[1][5]); zo.w = cvt_pk_bf16(cv[2][6] * cv[1][6], cv[2][7] * cv[1][7]);
            xo.x = cvt_pk_bf16(cv[0][0], cv[0][1]); xo.y = cvt_pk_bf16(cv[0][2], cv[0][3]); xo.z = cvt_pk_bf16(cv[0][4], cv[0][5]); xo.w = cvt_pk_bf16(cv[0][6], cv[0][7]);
            *(LAS u32x4*)(z + b * zs + (7 * 32 + t0) * 2) = zo; *(LAS u32x4*)((LAS unsigned char*)x0 + (b * L + t0) * 2) = xo; }
        for (int it = t; it < NBAT * 56; it += NT_) { const int b = it / 56, r = it - b * 56, side = r / 28, ch = r - side * 28;
            unsigned zz = 0u; asm volatile("" : "+v"(zz));
            *(LAS u32x4*)(z + b * zs + (side ? (L / 32 + 7) * 64 : 0) + ch * 16) = (u32x4){zz, zz, zz, zz}; }
    }
    __device__ __forceinline__ static void copies(int t, LAS unsigned char* rk, int rkstride) {
        constexpr int NCH = 2 * L / 8;
        for (int q = t; q < NCH; q += NT_) {
            const u32x4 lo = *(const LAS u32x4*)(rk + q * 16), hi = *(const LAS u32x4*)(rk + (q + 1 < NCH ? q + 1 : q) * 16);
            const unsigned cat[9] = {lo.x, lo.y, lo.z, lo.w, hi.x, hi.y, hi.z, hi.w, hi.w};
#pragma unroll
            for (int sft = 1; sft < 8; ++sft) { const int m = sft >> 1; u32x4 o;
                if (sft & 1) { o.x = __builtin_amdgcn_alignbyte(cat[m + 1], cat[m], 2); o.y = __builtin_amdgcn_alignbyte(cat[m + 2], cat[m + 1], 2); o.z = __builtin_amdgcn_alignbyte(cat[m + 3], cat[m + 2], 2); o.w = __builtin_amdgcn_alignbyte(cat[m + 4], cat[m + 3], 2); }
                else { o.x = cat[m]; o.y = cat[m + 1]; o.z = cat[m + 2]; o.w = cat[m + 3]; }
                *(LAS u32x4*)(rk + sft * rkstride + q * 16) = o; }
        }
    }
};
__device__ __forceinline__ void hy_epi(const f32x16& acc, const LAS unsigned char* z, int zs, const LAS bf16_t* x0, int L, int I0, int b0, float ds, bf16_t* yot, int tok0, int d, int lane) {
    const int h = lane >> 5, bl = (lane >> 3) & 3, Jl = lane & 7, b = b0 + bl;
#pragma unroll
    for (int g = 0; g < 4; ++g) { const int t = (I0 + Jl) * 32 + 8 * g + 4 * h; float o[4];
        const u32x2 zw = *(const LAS u32x2*)(z + b * zs + (7 * 32 + t) * 2), xw = *(const LAS u32x2*)((const LAS unsigned char*)x0 + (b * L + t) * 2);
        const float zz[4] = {bflo(zw.x), bfhi(zw.x), bflo(zw.y), bfhi(zw.y)}, xc[4] = {bflo(xw.x), bfhi(xw.x), bflo(xw.y), bfhi(xw.y)};
#pragma unroll
        for (int e = 0; e < 4; ++e) o[e] = (acc[4 * g + e] + zz[e] * ds) * xc[e];
        u32x2 w; w.x = cvt_pk_bf16(o[0], o[1]); w.y = cvt_pk_bf16(o[2], o[3]);
        *(u32x2*)(yot + (size_t)(tok0 + b * L) * 1024 + (size_t)d * L + t) = w; }
}
__device__ __forceinline__ void hyena_conv_phase(const KP& p, const int tid, LAS unsigned char* lds, int c, int G) {
    const int lane = tid & 63, wave = __builtin_amdgcn_readfirstlane(tid >> 6);
    bf16_t* YOT = (bf16_t*)(p.ws() + WS_YOT); const float* dsk = p.in(I_HYD);
    {
        constexpr int RKS = 8192 + 32, ZS = 78 * 64 + 32; LAS unsigned char* rk = lds; LAS unsigned char* z = lds + 8 * RKS; LAS bf16_t* x0 = (LAS bf16_t*)(z + 4 * ZS);
        HyCh<2048, 4, NTHR> R; if (c < 1024) R.load(p, tid, 4096, c);
        for (int d = c; d < 1024; d += G) {
            R.store(p, tid, d, rk, z, ZS, x0);
            __syncthreads();
            HyCh<2048, 4, NTHR>::copies(tid, rk, RKS);
            __syncthreads();
            if (d + G < 1024) R.load(p, tid, 4096, d + G);
            const int I0 = wave * 8; const f32x16 acc = conv_mfma(rk, RKS, z, ZS, 2048, I0, I0 - 63, I0 + 7, lane);
            hy_epi(acc, z, ZS, x0, 2048, I0, 0, dsk[d], YOT, 4096, d, lane);
            __syncthreads();
        }
    }
    {
        constexpr int RKS = 1024 + 32, ZS = 22 * 64 + 32, CH = 8 * RKS + 16 * ZS + 16 * 256 * 2; const int cs = wave >> 2, w4 = wave & 3, t2 = tid & 255;
        LAS unsigned char* rk = lds + cs * CH; LAS unsigned char* z = rk + 8 * RKS; LAS bf16_t* x0 = (LAS bf16_t*)(z + 16 * ZS);
        HyCh<256, 16, 256> R; if (c < 512) R.load(p, t2, 0, c * 2 + cs);
        for (int dp = c; dp < 512; dp += G) {
            const int d = dp * 2 + cs;
            R.store(p, t2, d, rk, z, ZS, x0);
            __syncthreads();
            HyCh<256, 16, 256>::copies(t2, rk, RKS);
            __syncthreads();
            if (dp + G < 512) R.load(p, t2, 0, (dp + G) * 2 + cs);
            const f32x16 acc = conv_mfma(rk, RKS, z + w4 * 4 * ZS, ZS, 256, 0, -7, 7, lane);
            hy_epi(acc, z, ZS, x0, 256, 0, w4 * 4, dsk[d], YOT, 0, d, lane);
            __syncthreads();
        }
    }
}
__device__ __forceinline__ void hyena_transpose_phase(const KP& p, LAS unsigned char* lds, int gw, int NGW, int lane, int wave) {
    const bf16_t* YOT = (const bf16_t*)(p.ws() + WS_YOT); bf16_t* YO = (bf16_t*)(p.ws() + WS_YO);
    LAS bf16_t* tl = (LAS bf16_t*)(lds + wave * (64 * 66 * 2));
    for (int it = gw; it < 192 * 16; it += NGW) {
        const int tt = it >> 4, dg = it & 15; int start, L, l0; { const int t0 = tt * 64; if (t0 < 4096) { start = t0 & ~255; L = 256; } else { start = 4096 + ((t0 - 4096) & ~2047); L = 2048; } l0 = t0 - start; }
        u32x4 vv[8];
#pragma unroll
        for (int j = 0; j < 8; ++j) { const int ch = j * 8 + (lane >> 3), tq = (lane & 7) * 8; vv[j] = *(const u32x4*)(YOT + (size_t)start * 1024 + (size_t)(dg * 64 + ch) * L + l0 + tq); }
#pragma unroll
        for (int j = 0; j < 8; ++j) { const int ch = j * 8 + (lane >> 3), tq = (lane & 7) * 8;
            const unsigned w[4] = {vv[j].x, vv[j].y, vv[j].z, vv[j].w};
#pragma unroll
            for (int e = 0; e < 4; ++e) { tl[(tq + 2 * e) * 66 + ch] = (bf16_t)(w[e] & 0xffffu); tl[(tq + 2 * e + 1) * 66 + ch] = (bf16_t)(w[e] >> 16); } }
        asm volatile("s_waitcnt lgkmcnt(0)" ::: "memory");
#pragma unroll
        for (int j = 0; j < 8; ++j) { const int t = j * 8 + (lane >> 3), cq = (lane & 7) * 8;
            u32x4 o; const LAS unsigned* src = (const LAS unsigned*)(tl + t * 66 + cq); o.x = src[0]; o.y = src[1]; o.z = src[2]; o.w = src[3];
            *(u32x4*)(YO + (size_t)(start + l0 + t) * 1024 + dg * 64 + cq) = o; }
        asm volatile("s_waitcnt lgkmcnt(0)" ::: "memory");
    }
}

constexpr int TC = 32;
constexpr int SCAN_GRP_LDS = 59904;
struct ScanRaw { u32x2 r, k, v, e, a; };
__device__ __forceinline__ void scan_load(ScanRaw& R, const bf16_t* RKV, const bf16_t* E, const bf16_t* AA, size_t ro) {
    R.r = *(const u32x2*)(RKV + ro); R.k = *(const u32x2*)(RKV + (size_t)T_TOK * 1024 + ro); R.v = *(const u32x2*)(RKV + (size_t)2 * T_TOK * 1024 + ro); R.e = *(const u32x2*)(E + ro); R.a = *(const u32x2*)(AA + ro);
}
__device__ __forceinline__ f32x4 unpk4(u32x2 w) { return (f32x4){bflo(w.x), bfhi(w.x), bflo(w.y), bfhi(w.y)}; }
__device__ __forceinline__ void scan_decode(int q, int& start, int& L, int& b, int& h, int& dir, int& half, bool& sample) {
    sample = q < 256;
    if (sample) { b = q >> 6; h = (q >> 2) & 15; dir = (q >> 1) & 1; half = q & 1; start = 4096 + b * 2048; L = 2048; }
    else { const int r = q - 256; b = r >> 5; h = (r >> 1) & 15; dir = r & 1; half = 0; start = b * 256; L = 256; }
}
__device__ __forceinline__ int scan_item_of(int c, int G, int grp, int i) {
    if (G == 256) { if (grp == 0) return i == 0 ? c : -1; return i < 2 ? 256 + 2 * c + i : -1; }
    const int q = (c * 2 + grp) + i * 2 * G; return q < 768 ? q : -1;
}
__device__ __forceinline__ int scan_slot_chunks(int c, int G, int grp) { int n = 0; for (int i = 0;; ++i) { const int q = scan_item_of(c, G, grp, i); if (q < 0) break; n += (q < 256 ? 2048 : 256) / TC; } return n; }
#define LO2(x) ((f32x2){(x)[0], (x)[1]})
#define HI2(x) ((f32x2){(x)[2], (x)[3]})
struct StepV { f32x4 k0, k1, q0, q1, w0, w1, b0, b1, d0, d1; f32x2 vv, bg; };
template <int NR>
__device__ __forceinline__ void scan_steps(const int dir, const int sk, const int kq, const int row0, LAS float* KKN, LAS float* Qs, LAS float* Ws, LAS float* Bs, LAS float* KDs, LAS float* Vs,
                                           LAS float* OBs, LAS float* BG, LAS float* DUMP, f32x2 (&sA)[4], f32x2 (&sB)[4]) {
#define SCAN_LD(V, st_) do { const int tl_ = dir == 0 ? (st_) : TC - 1 - (st_); const int o_ = tl_ * 64 + sk; \
    V.k0 = *(const LAS f32x4*)(KKN + o_); V.k1 = *(const LAS f32x4*)(KKN + o_ + 4); V.q0 = *(const LAS f32x4*)(Qs + o_); V.q1 = *(const LAS f32x4*)(Qs + o_ + 4); \
    V.w0 = *(const LAS f32x4*)(Ws + o_); V.w1 = *(const LAS f32x4*)(Ws + o_ + 4); V.b0 = *(const LAS f32x4*)(Bs + o_); V.b1 = *(const LAS f32x4*)(Bs + o_ + 4); \
    V.d0 = *(const LAS f32x4*)(KDs + o_); V.d1 = *(const LAS f32x4*)(KDs + o_ + 4); \
    if (NR == 2) V.vv = *(const LAS f32x2*)(Vs + tl_ * 64 + row0); else V.vv = (f32x2){Vs[tl_ * 64 + row0], 0.f}; V.bg = *(const LAS f32x2*)(BG + tl_ * 2); } while (0)
    StepV cur; SCAN_LD(cur, 0);
#pragma unroll 2
    for (int st = 0; st < TC; ++st) {
        const int tl = dir == 0 ? st : TC - 1 - st;
        StepV nxt; { const int sn = st + 1 < TC ? st + 1 : st; SCAN_LD(nxt, sn); }
        const f32x2 a0 = sA[0] * LO2(cur.k0) + sA[1] * HI2(cur.k0) + sA[2] * LO2(cur.k1) + sA[3] * HI2(cur.k1), p0 = sA[0] * LO2(cur.q0) + sA[1] * HI2(cur.q0) + sA[2] * LO2(cur.q1) + sA[3] * HI2(cur.q1);
        float sa0 = a0[0] + a0[1], pp0 = p0[0] + p0[1], sa1 = 0.f, pp1 = 0.f;
        if (NR == 2) { const f32x2 a1 = sB[0] * LO2(cur.k0) + sB[1] * HI2(cur.k0) + sB[2] * LO2(cur.k1) + sB[3] * HI2(cur.k1), p1 = sB[0] * LO2(cur.q0) + sB[1] * HI2(cur.q0) + sB[2] * LO2(cur.q1) + sB[3] * HI2(cur.q1);
            sa1 = a1[0] + a1[1]; pp1 = p1[0] + p1[1]; }
        if (NR == 2) {
#define SCAN_RED(NOP, CTRL) asm volatile(NOP "v_add_f32_dpp %0, %0, %0 " CTRL " row_mask:0xf bank_mask:0xf bound_ctrl:1\n\tv_add_f32_dpp %1, %1, %1 " CTRL " row_mask:0xf bank_mask:0xf bound_ctrl:1\n\t" \
                               "v_add_f32_dpp %2, %2, %2 " CTRL " row_mask:0xf bank_mask:0xf bound_ctrl:1\n\tv_add_f32_dpp %3, %3, %3 " CTRL " row_mask:0xf bank_mask:0xf bound_ctrl:1" : "+v"(sa0), "+v"(pp0), "+v"(sa1), "+v"(pp1))
            SCAN_RED("s_nop 1\n\t", "quad_perm:[1,0,3,2]"); SCAN_RED("", "quad_perm:[2,3,0,1]"); SCAN_RED("", "row_half_mirror");
#undef SCAN_RED
        } else {
#define SCAN_RED1(CTRL) asm volatile("s_nop 1\n\tv_add_f32_dpp %0, %0, %0 " CTRL " row_mask:0xf bank_mask:0xf bound_ctrl:1\n\tv_add_f32_dpp %1, %1, %1 " CTRL " row_mask:0xf bank_mask:0xf bound_ctrl:1" : "+v"(sa0), "+v"(pp0))
            SCAN_RED1("quad_perm:[1,0,3,2]"); SCAN_RED1("quad_perm:[2,3,0,1]"); SCAN_RED1("row_half_mirror");
#undef SCAN_RED1
        }
        const f32x2 sv0 = {sa0, sa0}, vv0 = {cur.vv[0], cur.vv[0]};
        sA[0] = sA[0] * LO2(cur.w0) + sv0 * LO2(cur.b0) + vv0 * LO2(cur.d0); sA[1] = sA[1] * HI2(cur.w0) + sv0 * HI2(cur.b0) + vv0 * HI2(cur.d0);
        sA[2] = sA[2] * LO2(cur.w1) + sv0 * LO2(cur.b1) + vv0 * LO2(cur.d1); sA[3] = sA[3] * HI2(cur.w1) + sv0 * HI2(cur.b1) + vv0 * HI2(cur.d1);
        if (NR == 2) { const f32x2 sv1 = {sa1, sa1}, vv1 = {cur.vv[1], cur.vv[1]};
            sB[0] = sB[0] * LO2(cur.w0) + sv1 * LO2(cur.b0) + vv1 * LO2(cur.d0); sB[1] = sB[1] * HI2(cur.w0) + sv1 * HI2(cur.b0) + vv1 * HI2(cur.d0);
            sB[2] = sB[2] * LO2(cur.w1) + sv1 * LO2(cur.b1) + vv1 * LO2(cur.d1); sB[3] = sB[3] * HI2(cur.w1) + sv1 * HI2(cur.b1) + vv1 * HI2(cur.d1);
            *(LAS f32x2*)(kq == 0 ? OBs + tl * 64 + row0 : DUMP) = (f32x2){pp0 + sa0 * cur.bg[0] + cur.vv[0] * cur.bg[1], pp1 + sa1 * cur.bg[0] + cur.vv[1] * cur.bg[1]}; }
        else *(kq == 0 ? OBs + tl * 64 + row0 : DUMP) = pp0 + sa0 * cur.bg[0] + cur.vv[0] * cur.bg[1];
        cur = nxt;
    }
#undef SCAN_LD
}
__device__ __forceinline__ void scan_prep_row(const ScanRaw& R, const int ptl, const int pkq, const int ppk, const f32x4 kkw, const f32x4 kaw, const f32x4 rkw, float* rho_dst, LAS float* base) {
    LAS float* KKN = base; LAS float* Qs = KKN + TC * 64; LAS float* Ws = Qs + TC * 64; LAS float* Bs = Ws + TC * 64; LAS float* KDs = Bs + TC * 64; LAS float* Vs = KDs + TC * 64; LAS float* BG = Vs + 2 * TC * 64;
    const f32x4 r4 = unpk4(R.r), k4 = unpk4(R.k), v4 = unpk4(R.v), e4 = unpk4(R.e), a4 = unpk4(R.a);
    f32x4 kk = k4 * kkw; float n2 = (kk[0] * kk[0] + kk[1] * kk[1]) + (kk[2] * kk[2] + kk[3] * kk[3]);
    n2 = sum16(n2);
    const float inv = 1.f / fmaxf(sqrtf(n2), 1e-12f); kk = kk * inv;
    f32x4 w;
#pragma unroll
    for (int e = 0; e < 4; ++e) w[e] = __expf(-e4[e]);
    const f32x4 kd = k4 * (1.f + (a4 - 1.f) * kaw), bb = kk * a4, q = w * r4;
    float be = (bb[0] * r4[0] + bb[1] * r4[1]) + (bb[2] * r4[2] + bb[3] * r4[3]), ga = (kd[0] * r4[0] + kd[1] * r4[1]) + (kd[2] * r4[2] + kd[3] * r4[3]);
    be = sum16(be); ga = sum16(ga);
    float rho = (r4[0] * kd[0] * rkw[0] + r4[1] * kd[1] * rkw[1]) + (r4[2] * kd[2] * rkw[2] + r4[3] * kd[3] * rkw[3]); rho = sum16(rho);
    if (pkq == 0 && rho_dst) *rho_dst = rho;
    const int o = ptl * 64 + ppk;
    *(LAS f32x4*)(KKN + o) = -kk; *(LAS f32x4*)(Qs + o) = q; *(LAS f32x4*)(Ws + o) = w; *(LAS f32x4*)(Bs + o) = bb; *(LAS f32x4*)(KDs + o) = kd; *(LAS f32x4*)(Vs + o) = v4;
    if (pkq == 0) { BG[ptl * 2] = be; BG[ptl * 2 + 1] = ga; }
}
__device__ __forceinline__ void scan_phase(const KP& p, const int tid, LAS unsigned char* lds_all, int c, int G) {
    const int grp = __builtin_amdgcn_readfirstlane(tid >> 8), t = tid & 255;
    const bf16_t* RKV = (const bf16_t*)(p.ws() + WS_RKV); float* RHO = (float*)(p.ws() + WS_L1);
    const int n0 = scan_slot_chunks(c, G, 0), n1 = scan_slot_chunks(c, G, 1), nslots = n0 > n1 ? n0 : n1;
    const bool hok = (G == 256) && (n1 & 1) == 0;
    const int prp = t >> 4, pkq = t & 15, ppk = pkq * 4;
    const int rp = t >> 3, kq = t & 7, sk = kq * 8;
    int item = -1, ch = 0, nch = 0, start = 0, L = 0, b = 0, h = 0, dir = 0, half = 0, row0 = 0; bool sample = false, done = false;
    const bf16_t* E = nullptr; const bf16_t* AA = nullptr; bf16_t* O = nullptr; int col = 0;
    f32x4 kkw = {0.f, 0.f, 0.f, 0.f}, kaw = {0.f, 0.f, 0.f, 0.f}, rkw = {0.f, 0.f, 0.f, 0.f};
    f32x2 sA[4], sB[4];
#pragma unroll
    for (int e = 0; e < 4; ++e) { sA[e] = (f32x2){0.f, 0.f}; sB[e] = (f32x2){0.f, 0.f}; }
    ScanRaw R0, R1;
    for (int gc = 0; gc < nslots; ++gc) {
        const bool asst = hok && gc >= n1 + 1;
        const bool helper = hok && grp == 1 && gc >= n1;
        if (helper && gc == n1) {
            scan_decode(scan_item_of(c, G, 0, 0), start, L, b, h, dir, half, sample); col = h * 64 + ppk;
            E = (const bf16_t*)(p.ws() + WS_E) + (size_t)dir * T_TOK * 1024; AA = (const bf16_t*)(p.ws() + WS_AA) + (size_t)dir * T_TOK * 1024; O = (bf16_t*)(p.ws() + (dir == 0 ? WS_OF : WS_OB));
            kkw = *(const f32x4*)(p.in(I_KK) + col); kaw = *(const f32x4*)(p.in(I_KA) + col); rkw = *(const f32x4*)(p.in(I_RK) + col); done = true; }
        if (!helper && !done && ch == nch) {
            ++item; const int q = scan_item_of(c, G, grp, item);
            if (q < 0) done = true;
            else { scan_decode(q, start, L, b, h, dir, half, sample); nch = L / TC; ch = 0; col = h * 64 + ppk; row0 = sample ? half * 32 + rp : 2 * rp;
                E = (const bf16_t*)(p.ws() + WS_E) + (size_t)dir * T_TOK * 1024; AA = (const bf16_t*)(p.ws() + WS_AA) + (size_t)dir * T_TOK * 1024; O = (bf16_t*)(p.ws() + (dir == 0 ? WS_OF : WS_OB));
                kkw = *(const f32x4*)(p.in(I_KK) + col); kaw = *(const f32x4*)(p.in(I_KA) + col); rkw = *(const f32x4*)(p.in(I_RK) + col);
#pragma unroll
                for (int e = 0; e < 4; ++e) { sA[e] = (f32x2){0.f, 0.f}; sB[e] = (f32x2){0.f, 0.f}; }
                if (sample) { const float* st = p.in(dir == 0 ? I_SF : I_SB) + (((size_t)b * 16 + h) * 64 + row0) * 64 + sk; const f32x4 a0 = *(const f32x4*)st, a1 = *(const f32x4*)(st + 4);
                    sA[0] = (f32x2){a0[0], a0[1]}; sA[1] = (f32x2){a0[2], a0[3]}; sA[2] = (f32x2){a1[0], a1[1]}; sA[3] = (f32x2){a1[2], a1[3]}; }
                const int tb0 = dir == 0 ? 0 : L - TC;
                scan_load(R0, RKV, E, AA, (size_t)(start + tb0 + prp) * 1024 + col); scan_load(R1, RKV, E, AA, (size_t)(start + tb0 + prp + 16) * 1024 + col); }
        }
        const bool active = !done && !helper; const int tbase = dir == 0 ? ch * TC : L - (ch + 1) * TC;
        LAS float* base = (LAS float*)(lds_all + ((grp == 0 && asst) ? (gc & 1) : grp) * SCAN_GRP_LDS);
        LAS float* KKN = base; LAS float* Qs = KKN + TC * 64; LAS float* Ws = Qs + TC * 64; LAS float* Bs = Ws + TC * 64; LAS float* KDs = Bs + TC * 64; LAS float* Vs = KDs + TC * 64;
        LAS float* OBs = Vs + TC * 64; LAS float* BG = OBs + TC * 64;
        LAS float* DUMP = (LAS float*)(lds_all + grp * SCAN_GRP_LDS) + 7 * TC * 64 + TC * 2 + t * 2;
        if (active && !(grp == 0 && asst)) {
            scan_prep_row(R0, prp, pkq, ppk, kkw, kaw, rkw, half == 0 ? RHO + ((size_t)dir * T_TOK + start + tbase + prp) * 16 + h : nullptr, base);
            scan_prep_row(R1, prp + 16, pkq, ppk, kkw, kaw, rkw, half == 0 ? RHO + ((size_t)dir * T_TOK + start + tbase + prp + 16) * 16 + h : nullptr, base);
        }
        if (helper) {
            const int kn = gc + 1; const bool do_prep = kn < nslots; ScanRaw H0, H1;
            const int tbn = dir == 0 ? kn * TC : L - (kn + 1) * TC;
            if (do_prep) { scan_load(H0, RKV, E, AA, (size_t)(start + tbn + prp) * 1024 + col); scan_load(H1, RKV, E, AA, (size_t)(start + tbn + prp + 16) * 1024 + col); }
            if (gc >= n1 + 2) { const int kp = gc - 1; const int tbp = dir == 0 ? kp * TC : L - (kp + 1) * TC; LAS float* ob = (LAS float*)(lds_all + (kp & 1) * SCAN_GRP_LDS) + 6 * TC * 64;
                const int otl = t >> 3, oc = half * 32 + (t & 7) * 4; const f32x4 o0 = *(const LAS f32x4*)(ob + otl * 64 + oc);
                u32x2 w; w.x = cvt_pk_bf16(o0[0], o0[1]); w.y = cvt_pk_bf16(o0[2], o0[3]); *(u32x2*)(O + (size_t)(start + tbp + otl) * 1024 + h * 64 + oc) = w; }
            if (do_prep) { LAS float* nb = (LAS float*)(lds_all + (kn & 1) * SCAN_GRP_LDS);
                scan_prep_row(H0, prp, pkq, ppk, kkw, kaw, rkw, half == 0 ? RHO + ((size_t)dir * T_TOK + start + tbn + prp) * 16 + h : nullptr, nb);
                scan_prep_row(H1, prp + 16, pkq, ppk, kkw, kaw, rkw, half == 0 ? RHO + ((size_t)dir * T_TOK + start + tbn + prp + 16) * 16 + h : nullptr, nb); }
        }
        if (!asst) __syncthreads();
        if (active) {
            if (ch + 1 < nch && !(grp == 0 && hok && gc + 1 >= n1 + 1)) { const int tb2 = dir == 0 ? (ch + 1) * TC : L - (ch + 2) * TC;
                scan_load(R0, RKV, E, AA, (size_t)(start + tb2 + prp) * 1024 + col); scan_load(R1, RKV, E, AA, (size_t)(start + tb2 + prp + 16) * 1024 + col); }
            if (sample) scan_steps<1>(dir, sk, kq, row0, KKN, Qs, Ws, Bs, KDs, Vs, OBs, BG, DUMP, sA, sB);
            else scan_steps<2>(dir, sk, kq, row0, KKN, Qs, Ws, Bs, KDs, Vs, OBs, BG, DUMP, sA, sB);
        }
        __syncthreads();
        if (active) {
            if (sample) { if (!(asst && gc + 1 < nslots)) { const int otl = t >> 3, oc = half * 32 + (t & 7) * 4; const f32x4 o0 = *(const LAS f32x4*)(OBs + otl * 64 + oc);
                u32x2 w; w.x = cvt_pk_bf16(o0[0], o0[1]); w.y = cvt_pk_bf16(o0[2], o0[3]); *(u32x2*)(O + (size_t)(start + tbase + otl) * 1024 + h * 64 + oc) = w; } }
            else { const int otl = t >> 3, oc = (t & 7) * 8; const f32x4 o0 = *(const LAS f32x4*)(OBs + otl * 64 + oc), o1 = *(const LAS f32x4*)(OBs + otl * 64 + oc + 4);
                u32x4 w; w.x = cvt_pk_bf16(o0[0], o0[1]); w.y = cvt_pk_bf16(o0[2], o0[3]); w.z = cvt_pk_bf16(o1[0], o1[1]); w.w = cvt_pk_bf16(o1[2], o1[3]);
                *(u32x4*)(O + (size_t)(start + tbase + otl) * 1024 + h * 64 + oc) = w; }
            ++ch;
            if (ch == nch && !sample) { float* so = p.out() + (size_t)T_TOK * 1024 + (size_t)dir * 1048576 + (((size_t)b * 16 + h) * 64 + row0) * 64 + sk;
                *(f32x4*)so = (f32x4){sA[0][0], sA[0][1], sA[1][0], sA[1][1]}; *(f32x4*)(so + 4) = (f32x4){sA[2][0], sA[2][1], sA[3][0], sA[3][1]};
                *(f32x4*)(so + 64) = (f32x4){sB[0][0], sB[0][1], sB[1][0], sB[1][1]}; *(f32x4*)(so + 68) = (f32x4){sB[2][0], sB[2][1], sB[3][0], sB[3][1]}; }
        }
    }
    __syncthreads();
}
#undef LO2
#undef HI2
__device__ __forceinline__ float sum32(float v) { v = sum16(v); return v + __builtin_bit_cast(float, __builtin_amdgcn_ds_swizzle(__builtin_bit_cast(int, v), 0x401F)); }
__device__ __forceinline__ void rwkv_post_phase(const KP& p, int gw, int NGW, int lane) {
    const bf16_t* RKV = (const bf16_t*)(p.ws() + WS_RKV); const bf16_t* Gb = (const bf16_t*)(p.ws() + WS_G);
    bf16_t* OF = (bf16_t*)(p.ws() + WS_OF); const bf16_t* OB = (const bf16_t*)(p.ws() + WS_OB); const float* RHO = (const float*)(p.ws() + WS_L1);
    const size_t TS = (size_t)T_TOK * 1024; const int hl = lane >> 5, l2 = (lane & 31) * 2;
    for (int pr0 = gw * 4; pr0 < T_TOK * 8; pr0 += NGW * 4) {
        unsigned wf[4], wb[4], wv[4], wg[4]; float r0[4], r1[4]; int hh[4]; size_t oo[4];
#pragma unroll
        for (int q = 0; q < 4; ++q) { const int pr = pr0 + q, row = pr >> 3, h = (pr & 7) * 2 + hl; const size_t o = (size_t)row * 1024 + h * 64 + l2; hh[q] = h; oo[q] = o;
            wf[q] = *(const unsigned*)(OF + o); wb[q] = *(const unsigned*)(OB + o); wv[q] = *(const unsigned*)(RKV + 2 * TS + o); wg[q] = *(const unsigned*)(Gb + o);
            r0[q] = RHO[(size_t)row * 16 + h]; r1[q] = RHO[((size_t)T_TOK + row) * 16 + h]; }
#pragma unroll
        for (int q = 0; q < 4; ++q) { const int cc = hh[q] * 64 + l2;
            const float o0 = bflo(wf[q]) + bflo(wb[q]), o1 = bfhi(wf[q]) + bfhi(wb[q]);
            const float mu = sum32(o0 + o1) * (1.f / 64.f), d0 = o0 - mu, d1 = o1 - mu; const float var = sum32(d0 * d0 + d1 * d1) * (1.f / 64.f), rs = rsqrtf(var + 64e-5f);
            const f32x2 lw = *(const f32x2*)(p.in(I_LNW) + cc), lb = *(const f32x2*)(p.in(I_LNB) + cc);
            const float rho = r0[q] + r1[q];
            const float on0 = d0 * rs * lw[0] + lb[0] + rho * bflo(wv[q]), on1 = d1 * rs * lw[1] + lb[1] + rho * bfhi(wv[q]);
            *(unsigned*)(OF + oo[q]) = cvt_pk_bf16(on0 * bflo(wg[q]), on1 * bfhi(wg[q])); }
    }
}

__device__ __forceinline__ void mix_phase(const KP& p, int gw, int NGW, int lane) {
    const bf16_t* H = (const bf16_t*)(p.ws() + WS_H); bf16_t* XM = (bf16_t*)(p.ws() + WS_XM); const float* mix = p.in(I_MIX);
    for (int it = gw; it < (T_TOK / 2) * 4; it += NGW) {
        const int j = it & 3, r = (it >> 2) * 2, cc = 4 * lane + 256 * j; int s0, s1; if (r < 4096) { s0 = r & ~255; s1 = s0 + 256; } else { s0 = 4096 + ((r - 4096) & ~2047); s1 = s0 + 2048; }
        const size_t o = (size_t)r * 1024 + cc;
        const u32x2 w0 = *(const u32x2*)(H + (r > s0 ? o - 1024 : o)), w1 = *(const u32x2*)(H + o), w2 = *(const u32x2*)(H + o + 1024), w3 = *(const u32x2*)(H + (r + 2 < s1 ? o + 2048 : o));
        f32x4 mx[6];
#pragma unroll
        for (int m = 0; m < 6; ++m) mx[m] = *(const f32x4*)(mix + m * 1024 + cc);
        const float k0 = r > s0 ? 1.f : 0.f, k3 = r + 2 < s1 ? 1.f : 0.f;
        const f32x4 h0 = unpk4(w0) * k0, h1 = unpk4(w1), h2 = unpk4(w2), h3 = unpk4(w3) * k3;
        const f32x4 xa = 0.5f * (h0 + h2) - h1, xb = 0.5f * (h1 + h3) - h2;
#pragma unroll
        for (int m = 0; m < 6; ++m) { const int slot = m == 0 ? 0 : (m == 1 ? 3 : (m == 2 ? 1 : (m == 3 ? 2 : m))); const f32x4 va = h1 + xa * mx[m], vb = h2 + xb * mx[m];
            u32x2 wa, wb; wa.x = cvt_pk_bf16(va[0], va[1]); wa.y = cvt_pk_bf16(va[2], va[3]); wb.x = cvt_pk_bf16(vb[0], vb[1]); wb.y = cvt_pk_bf16(vb[2], vb[3]);
            *(u32x2*)(XM + (size_t)slot * T_TOK * 1024 + o) = wa; *(u32x2*)(XM + (size_t)slot * T_TOK * 1024 + o + 1024) = wb; }
    }
}

#define XB_TMO      128
#define XB_XCNT(j)  (256  + 64 * (j))
#define XB_XSUB(j)  (1280 + 64 * (j))
#define XB_XGEN(j)  (2304 + 64 * (j))
#define XB_TOP      3328
#define XB_TOPGEN   3392
#define XCD_BAR_WORDS 3456
#define XB_SPIN_CAP (1u << 18)

__device__ __forceinline__ unsigned xb_ld(unsigned* p)              { return __hip_atomic_load(p, __ATOMIC_RELAXED, __HIP_MEMORY_SCOPE_AGENT); }
__device__ __forceinline__ unsigned xb_add(unsigned* p, unsigned v) { return __hip_atomic_fetch_add(p, v, __ATOMIC_RELAXED, __HIP_MEMORY_SCOPE_AGENT); }
__device__ __forceinline__ unsigned xb_xcc_id() { return (unsigned)__builtin_amdgcn_s_getreg((3 << 11) | 20) & 0xFu; }
#define XB_SPIN(cond, bar) do { unsigned _sp = 0; while (cond) { __builtin_amdgcn_s_sleep(1); \
    if ((++_sp & 255u) == 0u) { if (xb_ld(&(bar)[XB_TMO])) break; if (_sp > XB_SPIN_CAP) { xb_add(&(bar)[XB_TMO], 1u); break; } } } } while (0)

struct XcdBarrier {
    unsigned* bar; unsigned x;
    volatile LAS unsigned* st;
};

__device__ __forceinline__ XcdBarrier xcd_barrier_post(unsigned* bar, volatile LAS unsigned* st) {
    XcdBarrier b; b.bar = bar; b.x = xb_xcc_id(); b.st = st;
    if (threadIdx.x == 0) (void)xb_add(&bar[XB_XCNT(b.x)], 1u);
    return b;
}
__device__ __forceinline__ void xcd_barrier_complete(unsigned* bar, unsigned x, unsigned& nloc, unsigned& nx) {
    const unsigned G = gridDim.x * gridDim.y * gridDim.z;
    unsigned sum, cnt, mine, sp = 0u;
    for (;;) {
        sum = 0u; cnt = 0u; mine = 0u;
#pragma unroll
        for (unsigned j = 0; j < 16; ++j) { const unsigned c = xb_ld(&bar[XB_XCNT(j)]); sum += c; cnt += (c > 0u) ? 1u : 0u; mine = (j == x) ? c : mine; }
        if (sum == G) break;
        __builtin_amdgcn_s_sleep(1);
        if ((++sp & 255u) == 0u) { if (xb_ld(&bar[XB_TMO])) break; if (sp > XB_SPIN_CAP) { xb_add(&bar[XB_TMO], 1u); break; } }
    }
    nloc = mine > 0u ? mine : 1u; nx = cnt > 0u ? cnt : 1u;
}

__device__ __forceinline__ void xcd_barrier(const XcdBarrier& b) {
    asm volatile("s_waitcnt vmcnt(0)" ::: "memory");
    __syncthreads();
    if (threadIdx.x == 0) {
        unsigned* bar = b.bar;
        __builtin_amdgcn_s_waitcnt(0);
        unsigned nloc = b.st[0], nx = b.st[1];
        if (nloc == 0u) { xcd_barrier_complete(bar, b.x, nloc, nx); b.st[0] = nloc; b.st[1] = nx; }
        const unsigned old = xb_add(&bar[XB_XSUB(b.x)], 1u);
        const unsigned gen = old / nloc;
        if (old + 1u == (gen + 1u) * nloc) {
            __builtin_amdgcn_fence(__ATOMIC_RELEASE, "agent");
            asm volatile("s_waitcnt vmcnt(0)" ::: "memory");
            const unsigned og = xb_add(&bar[XB_TOP], 1u);
            const unsigned tg = og / nx;
            if (og + 1u == (tg + 1u) * nx) xb_add(&bar[XB_TOPGEN], 1u);
            else XB_SPIN(xb_ld(&bar[XB_TOPGEN]) == tg, bar);
            __builtin_amdgcn_fence(__ATOMIC_ACQUIRE, "agent");
            xb_add(&bar[XB_XGEN(b.x)], 1u);
            asm volatile("s_waitcnt vmcnt(0)" ::: "memory");
        } else {
            XB_SPIN(xb_ld(&bar[XB_XGEN(b.x)]) == gen, bar);
            __builtin_amdgcn_fence(__ATOMIC_ACQUIRE, "agent");
            asm volatile("s_waitcnt vmcnt(0)" ::: "memory");
        }
    }
    __syncthreads();
}

#define PE(code, l, nosync) (unsigned char)((code) | ((l) << 5) | ((nosync) << 7))
__device__ const unsigned char PROG[36] = {
    PE(PH_PREP, 0, 0), PE(PH_R0, 0, 0),
    PE(PH_FG1, 0, 0), PE(PH_FG2S, 0, 1), PE(PH_FG2P, 0, 0), PE(PH_FG3, 0, 0), PE(PH_RMID, 0, 0), PE(PH_NG1, 0, 0), PE(PH_NG2, 0, 0), PE(PH_REND, 0, 0),
    PE(PH_HG1, 1, 0), PE(PH_HC, 1, 0), PE(PH_HT, 1, 0), PE(PH_HG2, 1, 0), PE(PH_RMID, 1, 0), PE(PH_NG1, 1, 0), PE(PH_NG2, 1, 0), PE(PH_REND, 1, 0), PE(PH_MIX, 1, 0),
    PE(PH_RG1, 2, 0), PE(PH_RG2, 2, 0), PE(PH_RS, 2, 0), PE(PH_RP, 2, 0), PE(PH_RG3, 2, 0), PE(PH_RMID, 2, 0), PE(PH_NG1, 2, 0), PE(PH_NG2, 2, 0), PE(PH_REND, 2, 0),
    PE(PH_FG1, 3, 0), PE(PH_FG2S, 3, 1), PE(PH_FG2P, 3, 0), PE(PH_FG3, 3, 0), PE(PH_RMID, 3, 0), PE(PH_NG1, 3, 0), PE(PH_NG2, 3, 0), PE(PH_REND, 3, 1) };

__global__ void __launch_bounds__(NTHR) mega_fwd(Params pp) {
    extern __shared__ __attribute__((aligned(16))) unsigned char lds_raw[];
    volatile LAS unsigned* xst = (volatile LAS unsigned*)((LAS unsigned char*)lds_raw + 160000);
    if (threadIdx.x < 2) xst[threadIdx.x] = 0u;
    __syncthreads();
    unsigned* xbar_words; { const KP p0{(kin_t)__builtin_amdgcn_kernarg_segment_ptr()}; xbar_words = (unsigned*)(p0.ws() + WS_CTL); }
    XcdBarrier xbar; xbar.bar = xbar_words; xbar.x = xb_xcc_id(); xbar.st = xst;
    if (blockIdx.x == 0) { for (int i = threadIdx.x; i < (int)(CTL_BYTES / 16); i += NTHR) ((u32x4*)xbar_words)[i] = (u32x4){0u, 0u, 0u, 0u}; }
#ifndef PROBE_CLASS
#define PROBE_CLASS 0
#endif
    unsigned long long tacc = 0ull;
#pragma unroll 1
    for (int ph = 0; ph < 36; ++ph) {
        unsigned long long kv = (unsigned long long)__builtin_amdgcn_kernarg_segment_ptr(); asm volatile("" : "+s"(kv));
        int tid = threadIdx.x; asm volatile("" : "+v"(tid));
        int G = gridDim.x, bx = blockIdx.x; asm volatile("" : "+s"(G), "+s"(bx));
        unsigned ldsv = (unsigned)(size_t)(LAS unsigned char*)lds_raw; asm volatile("" : "+s"(ldsv));
        LAS unsigned char* lds = (LAS unsigned char*)(size_t)ldsv;
        const int lane = tid & 63, wave = __builtin_amdgcn_readfirstlane(tid >> 6);
        const int c = (G % 8 == 0) ? (bx % 8) * (G / 8) + bx / 8 : bx;
        const int gw = c * NWAVES + wave, NGW = G * NWAVES, gtid = c * NTHR + tid, NT = G * NTHR;
        LAS float* scr = (LAS float*)(lds + wave * 8448);
        const KP p{(kin_t)kv}; unsigned char* ws = p.ws(); const float* MOD = (const float*)(ws + WS_MOD);
        const unsigned pe = PROG[ph]; const int code = pe & 31, l = (pe >> 5) & 3; const bool nosync = (pe >> 7) != 0;
        unsigned long long tp0 = 0ull; if (PROBE_CLASS) tp0 = __builtin_amdgcn_s_memrealtime();
        const bool fuse = (G == 256);
        if (fuse && (code == PH_RMID || code == PH_REND)) continue;
        if (code == PH_MIX) { if (!fuse) continue; mix_phase(p, gw, NGW, lane); }
        else if (code >= 8) {
            int lda = 1024, ldb = 1024, nt = 16;
            if (code == PH_FG1) { lda = 256; nt = 4; } else if (code == PH_FG2S) { lda = 4096; ldb = 4096; nt = 64; } else if (code == PH_FG2P) { lda = 512; ldb = 512; nt = 8; }
            else if (code == PH_RG2) { lda = 384; ldb = 256; nt = 4; } else if (code == PH_NG2) { lda = FF; ldb = FF; nt = 44; }
            if (G == 256 && (c & 31) >= 24 && (code == PH_FG3 || code == PH_HG2 || code == PH_RG3)) convert_ffn(p, l, scr, ((c >> 5) * 8 + (c & 31) - 24) * NWAVES + wave, 64 * NWAVES, lane);
            if (G > 192 && G != 256 && c >= 192 && (code == PH_FG3 || code == PH_HG2 || code == PH_RG3)) convert_ffn(p, l, scr, (c - 192) * NWAVES + wave, (G - 192) * NWAVES, lane);
            if (G > 192 && c >= 192 && code == PH_FG2S && l == 0) p0_hyfilter(p, tid, (LAS float*)lds, c - 192, G - 192);
            SchedAny S{code, l, G, c, ws, fuse}; const EpiGen E{code, l, c, p};
            gemm_phase<true>(tid, lds, lda, ldb, nt, S, E);
        } else if (code == PH_PREP) {
            if (G == 256) {
                if (c < 96) p0_mod(p, tid, (LAS float*)lds, c, 96);
                else { p0_transposes(p, scr, (c - 96) * NWAVES + wave, 160 * NWAVES, lane); p0_tables(p, (c - 96) * NTHR + tid, 160 * NTHR); }
            } else {
            p0_transposes(p, scr, gw, NGW, lane);
            p0_tables(p, gtid, NT);
            __syncthreads();
            p0_mod(p, tid, (LAS float*)lds, c, G);
            }
            if (G <= 192) p0_hyfilter(p, tid, (LAS float*)lds, c, G);
        } else if (code == PH_HC) {
            hyena_conv_phase(p, tid, lds, c, G);
        } else if (code == PH_HT) {
            hyena_transpose_phase(p, lds, gw, NGW, lane, wave);
        } else if (code == PH_RS) {
            scan_phase(p, tid, lds, c, G);
        } else if (code == PH_RP) {
            rwkv_post_phase(p, gw, NGW, lane);
        } else {
            const float* modl = MOD + (size_t)l * 5 * 6144; const float* ngl = p.in(I_NG) + (size_t)l * 4 * 1024;
            RowCfg cf; cf.h = (bf16_t*)(ws + WS_H); cf.mix = p.in(I_MIX); cf.xm = (bf16_t*)(ws + WS_XM); cf.y = (const bf16_t*)(ws + WS_Y);
            cf.xs_p = (const float*)(ws + WS_X); cf.xs_s = (const float*)(ws + WS_X) + (size_t)4096 * 1024; cf.xdst = (float*)(ws + WS_X);
            bool rw = false;
            if (code == PH_R0) { cf.xs_p = p.in(I_XP); cf.xs_s = p.in(I_XS); cf.xdst = nullptr; cf.y = nullptr; cf.gate = nullptr; cf.ng_post = nullptr; cf.ng_pre = ngl; cf.sc = modl + 1024; cf.sh = modl; }
            else if (code == PH_RMID) {
                if (G <= 192) convert_ffn(p, l, scr, gw, NGW, lane);
                if (l == 0) { cf.xs_p = p.in(I_XP); cf.xs_s = p.in(I_XS); }
                if (l == 2) { cf.xs_p = p.out(); cf.xs_s = p.out() + (size_t)4096 * 1024; }
                cf.gate = modl + 2048; cf.ng_post = ngl + 1024; cf.ng_pre = ngl + 2048; cf.sc = modl + 4096; cf.sh = modl + 3072;
            } else {
                cf.gate = modl + 5120; cf.ng_post = ngl + 3072;
                if (l == 3) { cf.xdst = p.out(); cf.ng_pre = nullptr; cf.sc = nullptr; cf.sh = nullptr; }
                else { cf.ng_pre = ngl + 4096; cf.sc = modl + 5 * 6144 + 1024; cf.sh = modl + 5 * 6144; rw = ((l + 1) % 3 == 2); if (rw) cf.xdst = p.out(); }
            }
            if (rw) row_phase<true>(cf, gw, NGW, lane); else row_phase<false>(cf, gw, NGW, lane);
        }
        if (PROBE_CLASS) {
            const int cls = (code == PH_PREP) ? 2 : (code == PH_R0 || code == PH_RMID || code == PH_REND) ? 3 : (code == PH_NG1 || code == PH_NG2) ? 4 : (code >= 8) ? 5 : (code == PH_HC || code == PH_HT) ? 6 : (code == PH_RS) ? 7 : 8;
            __syncthreads(); const unsigned long long tp1 = __builtin_amdgcn_s_memrealtime();
            if (cls == PROBE_CLASS) tacc += tp1 - tp0;
            if (!nosync) { if (ph == 0) { cg::this_grid().sync(); if (threadIdx.x == 0) (void)xb_add(&xbar.bar[XB_XCNT(xbar.x)], 1u); } else xcd_barrier(xbar); }
            if (PROBE_CLASS == 1) tacc += __builtin_amdgcn_s_memrealtime() - tp1;
        } else {
        if (!nosync) { if (ph == 0) { cg::this_grid().sync(); if (threadIdx.x == 0) (void)xb_add(&xbar.bar[XB_XCNT(xbar.x)], 1u); } else xcd_barrier(xbar); }
        }
    }
    if (PROBE_CLASS) { if (blockIdx.x == 0 && threadIdx.x == 0) { float* o = (float*)((const float* const __attribute__((address_space(4)))*)__builtin_amdgcn_kernarg_segment_ptr())[45]; o[(size_t)T_TOK * 1024] += (float)tacc * 1e-4f; } }
}

extern "C" void kernel_launch(void* const* d_in, const int* in_sizes, int n_in, void* d_out, int out_size, void* d_ws, size_t ws_size, hipStream_t stream) {
    static int grid = 0;
    if (grid == 0) {
        if (n_in != 45 || ws_size < WS_END) { fprintf(stderr, "kernel_launch: need 45 inputs and %zu bytes of workspace; got %d, %zu\n", (size_t)WS_END, n_in, ws_size); grid = -1; return; }
        int dev = 0, cus = 0, per_cu = 0;
        hipGetDevice(&dev); hipDeviceGetAttribute(&cus, hipDeviceAttributeMultiprocessorCount, dev);
        if (hipFuncSetAttribute((const void*)mega_fwd, hipFuncAttributeMaxDynamicSharedMemorySize, LDS_BYTES) != hipSuccess) { fprintf(stderr, "kernel_launch: hipFuncSetAttribute failed\n"); grid = -1; return; }
        if (hipOccupancyMaxActiveBlocksPerMultiprocessor(&per_cu, (const void*)mega_fwd, NTHR, LDS_BYTES) != hipSuccess || per_cu < 1) { fprintf(stderr, "kernel_launch: occupancy query failed (%d)\n", per_cu); (void)hipGetLastError(); per_cu = 1; }
        grid = cus * 1;
    }
    if (grid < 0) return;
    Params a{};
    for (int i = 0; i < 45; ++i) a.in[i] = (const float*)d_in[i];
    a.out = (float*)d_out; a.ws = (unsigned char*)d_ws;
    void* args[] = {&a};
    hipError_t e = hipLaunchCooperativeKernel((const void*)mega_fwd, dim3(grid), dim3(NTHR), args, LDS_BYTES, stream);
    if (e != hipSuccess) fprintf(stderr, "cooperative launch failed: %s (grid %d)\n", hipGetErrorString(e), grid);
}
```
